# Optimizing an MI355X kernel written in HIP

```python
import jax, jax.numpy as jnp
from jax import lax
import numpy as np

D_MODEL = 2048
BATCH = 4
SEQ = 2048
DEPTH = 1

HEAD_DIM = 128
N_HEADS_FOX = 8
N_HEADS_MOBA = 8
WIDTH_FOX = N_HEADS_FOX * HEAD_DIM
WIDTH_MOBA = N_HEADS_MOBA * HEAD_DIM
FOX_Q_BLOCK = 128
MOBA_BLOCK = 256
MOBA_TOPK = 3
MOBA_Q_CHUNK = 16
D_FF = -(-(8 * D_MODEL) // (3 * 256)) * 256
ROPE_THETA = 10000.0
RMS_EPS = 1e-6
IN_COLS = 3 * WIDTH_FOX + 3 * WIDTH_MOBA + N_HEADS_FOX + 2 * D_MODEL

kernel_name = "hybrid_fox_moba_gated_swiglu"


def rms_norm(x, g):
    xf = x.astype(jnp.float32)
    y = xf * lax.rsqrt(jnp.mean(xf * xf, axis=-1, keepdims=True) + RMS_EPS)
    return (y * g.astype(jnp.float32)).astype(x.dtype)


def to_heads(t, n_heads):
    b, s, _ = t.shape
    return t.reshape(b, s, n_heads, HEAD_DIM).transpose(0, 2, 1, 3)


def from_heads(t):
    b, h, s, d = t.shape
    return t.transpose(0, 2, 1, 3).reshape(b, s, h * d)


def rotary(t):
    s = t.shape[2]
    half = HEAD_DIM // 2
    inv_freq = ROPE_THETA ** (-jnp.arange(half, dtype=jnp.float32) / half)
    ang = jnp.arange(s, dtype=jnp.float32)[:, None] * inv_freq[None, :]
    cos, sin = jnp.cos(ang), jnp.sin(ang)
    tf = t.astype(jnp.float32)
    t1, t2 = tf[..., :half], tf[..., half:]
    out = jnp.concatenate([t1 * cos - t2 * sin, t2 * cos + t1 * sin], axis=-1)
    return out.astype(t.dtype)


def forgetting_attention(q, k, v, log_f):
    b, h, s, _ = q.shape
    c = jnp.cumsum(log_f, axis=-1)
    scale = HEAD_DIM ** -0.5
    kpos = jnp.arange(s)

    def block(start):
        qb = lax.dynamic_slice_in_dim(q, start, FOX_Q_BLOCK, axis=2)
        cb = lax.dynamic_slice_in_dim(c, start, FOX_Q_BLOCK, axis=2)
        qpos = start + jnp.arange(FOX_Q_BLOCK)
        logits = jnp.einsum('bhqd,bhkd->bhqk', qb, k,
                            preferred_element_type=jnp.float32) * scale
        logits = logits + (cb[..., :, None] - c[..., None, :])
        logits = jnp.where(kpos[None, :] <= qpos[:, None], logits, -jnp.inf)
        p = jax.nn.softmax(logits, axis=-1)
        return jnp.einsum('bhqk,bhkd->bhqd', p.astype(v.dtype), v)

    starts = jnp.arange(0, s, FOX_Q_BLOCK)
    out = lax.map(block, starts)
    return out.transpose(1, 2, 0, 3, 4).reshape(b, h, s, HEAD_DIM)


def moba_attention(q, k, v):
    b, h, s, _ = q.shape
    n_blocks = -(-s // MOBA_BLOCK)
    s_pad = n_blocks * MOBA_BLOCK
    pad = ((0, 0), (0, 0), (0, s_pad - s), (0, 0))
    kp = jnp.pad(k, pad)
    vp = jnp.pad(v, pad)
    kb = kp.reshape(b, h, n_blocks, MOBA_BLOCK, HEAD_DIM)
    vb = vp.reshape(b, h, n_blocks, MOBA_BLOCK, HEAD_DIM)
    k_mean = jnp.mean(kb.astype(jnp.float32), axis=3)
    topk = min(MOBA_TOPK, n_blocks)
    scale = HEAD_DIM ** -0.5
    block_ids = jnp.arange(n_blocks)
    gather = jax.vmap(jax.vmap(lambda tbl, ids: tbl[ids]))

    def chunk(start):
        qc = lax.dynamic_slice_in_dim(q, start, MOBA_Q_CHUNK, axis=2)
        blk = start // MOBA_BLOCK
        qpos = start + jnp.arange(MOBA_Q_CHUNK)
        gate = jnp.einsum('bhqd,bhnd->bhqn', qc.astype(jnp.float32), k_mean)
        gate = jnp.where(block_ids < blk, gate, -jnp.inf)
        _, idx = lax.top_k(gate, topk)
        valid = idx < blk
        k_sel = gather(kb, idx)
        v_sel = gather(vb, idx)
        s_sel = jnp.einsum('bhqd,bhqnkd->bhqnk', qc, k_sel,
                           preferred_element_type=jnp.float32) * scale
        s_sel = jnp.where(valid[..., None], s_sel, -jnp.inf)
        s_sel = s_sel.reshape(b, h, MOBA_Q_CHUNK, topk * MOBA_BLOCK)
        k_own = lax.dynamic_slice_in_dim(kp, blk * MOBA_BLOCK, MOBA_BLOCK, axis=2)
        v_own = lax.dynamic_slice_in_dim(vp, blk * MOBA_BLOCK, MOBA_BLOCK, axis=2)
        kpos = blk * MOBA_BLOCK + jnp.arange(MOBA_BLOCK)
        s_own = jnp.einsum('bhqd,bhkd->bhqk', qc, k_own,
                           preferred_element_type=jnp.float32) * scale
        s_own = jnp.where(kpos[None, :] <= qpos[:, None], s_own, -jnp.inf)
        p = jax.nn.softmax(jnp.concatenate([s_sel, s_own], axis=-1), axis=-1)
        p_sel = p[..., :topk * MOBA_BLOCK].reshape(b, h, MOBA_Q_CHUNK, topk, MOBA_BLOCK)
        p_own = p[..., topk * MOBA_BLOCK:]
        out = (jnp.einsum('bhqnk,bhqnkd->bhqd', p_sel.astype(v.dtype), v_sel)
               + jnp.einsum('bhqk,bhkd->bhqd', p_own.astype(v.dtype), v_own))
        return out

    starts = jnp.arange(0, s, MOBA_Q_CHUNK)
    out = lax.map(chunk, starts)
    return out.transpose(1, 2, 0, 3, 4).reshape(b, h, s, HEAD_DIM)


def split_offsets():
    sizes = [WIDTH_FOX] * 3 + [WIDTH_MOBA] * 3 + [N_HEADS_FOX, D_MODEL]
    offs, acc = [], 0
    for sz in sizes:
        acc += sz
        offs.append(acc)
    return offs


def setup_inputs(seed: int = 0) -> dict:
    key = jax.random.key(seed)
    ks = jax.random.split(key, 12)
    f32 = jnp.float32

    def nrm(k, shape, fan_in):
        return jax.random.normal(k, shape, f32) * (fan_in ** -0.5)

    x = jax.random.normal(ks[0], (BATCH, SEQ, D_MODEL), f32)
    norm_mix = 1.0 + 0.02 * jax.random.normal(ks[1], (DEPTH, D_MODEL), f32)
    w_in = nrm(ks[2], (DEPTH, D_MODEL, IN_COLS), D_MODEL)
    b_forget = (jnp.linspace(1.0, 5.0, N_HEADS_FOX, dtype=f32)[None, :]
                + 0.1 * jax.random.normal(ks[3], (DEPTH, N_HEADS_FOX), f32))
    w_o_fox = nrm(ks[4], (DEPTH, WIDTH_FOX, D_MODEL), WIDTH_FOX)
    w_o_moba = nrm(ks[5], (DEPTH, WIDTH_MOBA, D_MODEL), WIDTH_MOBA)
    w_out = nrm(ks[6], (DEPTH, D_MODEL, D_MODEL), D_MODEL)
    norm_ffn = 1.0 + 0.02 * jax.random.normal(ks[7], (DEPTH, D_MODEL), f32)
    w_gate_up = nrm(ks[8], (DEPTH, D_MODEL, 2 * D_FF), D_MODEL)
    w_down = nrm(ks[9], (DEPTH, D_FF, D_MODEL), D_FF)
    norm_final = 1.0 + 0.02 * jax.random.normal(ks[10], (D_MODEL,), f32)
    return {"x": x, "norm_mix": norm_mix, "w_in": w_in, "b_forget": b_forget,
            "w_o_fox": w_o_fox, "w_o_moba": w_o_moba, "w_out": w_out,
            "norm_ffn": norm_ffn, "w_gate_up": w_gate_up, "w_down": w_down,
            "norm_final": norm_final}


def reference(x, norm_mix, w_in, b_forget, w_o_fox, w_o_moba, w_out,
              norm_ffn, w_gate_up, w_down, norm_final):
    offs = split_offsets()
    for layer in range(DEPTH):
        h = rms_norm(x, norm_mix[layer])
        proj = h @ w_in[layer]
        q_a, k_a, v_a, q_b, k_b, v_b, f_logit, g_a, g_b = jnp.split(proj, offs, axis=-1)
        log_f = jax.nn.log_sigmoid(
            (f_logit + b_forget[layer]).astype(jnp.float32)).transpose(0, 2, 1)
        o_a = forgetting_attention(to_heads(q_a, N_HEADS_FOX), to_heads(k_a, N_HEADS_FOX),
                                   to_heads(v_a, N_HEADS_FOX), log_f)
        o_b = moba_attention(rotary(to_heads(q_b, N_HEADS_MOBA)),
                             rotary(to_heads(k_b, N_HEADS_MOBA)),
                             to_heads(v_b, N_HEADS_MOBA))
        y = (jax.nn.sigmoid(g_a) * (from_heads(o_a) @ w_o_fox[layer])
             + jax.nn.sigmoid(g_b) * (from_heads(o_b) @ w_o_moba[layer]))
        x = x + y @ w_out[layer]
        h = rms_norm(x, norm_ffn[layer])
        gate, up = jnp.split(h @ w_gate_up[layer], [D_FF], axis=-1)
        x = x + (jax.nn.silu(gate) * up) @ w_down[layer]
    return rms_norm(x, norm_final)
```

```cpp
#include <hip/hip_runtime.h>
#include <hip/hip_cooperative_groups.h>
#include <cstdio>
#include <cstdint>
#include <cmath>
namespace cg = cooperative_groups;
namespace pg8 {
#define PG8_LAS __attribute__((address_space(3)))
typedef unsigned short bf16_t;
typedef short bf16x8 __attribute__((ext_vector_type(8)));
typedef float f32x4 __attribute__((ext_vector_type(4)));
typedef unsigned u32x4 __attribute__((ext_vector_type(4)));
constexpr int BM = 256, BK = 64, HALF = 128, HTB = HALF * BK * 2  , STAGE_BYTES = 8 * HTB, NXCD = 8, WGM = 8;

__host__ __device__ __forceinline__ int lds_byte(int r, int c) { const int st = (r >> 4) * 2 + (c >> 5), rr = r & 15, cc = c & 31, ob = rr * 64 + cc * 2; return st * 1024 + (ob ^ (((ob >> 9) & 1) << 5)); }
__host__ __device__ __forceinline__ void stage_rc(int b, int& R, int& C) { const int st = b / 1024, sb = b % 1024, swz = sb ^ (((sb >> 9) & 1) << 5); R = (st >> 1) * 16 + swz / 64; C = (st & 1) * 32 + (swz % 64) / 2; }
__host__ __device__ __forceinline__ int perm32(int rho) { const int n = rho >> 4, i = rho & 15; return 8 * (i >> 2) + 4 * n + (i & 3); }

struct Unit { int pm, pn, kofs; };
struct Gemm { const bf16_t* A; const bf16_t* Bt; int lda, ldb, K; };

struct StaticOrder {
    int nM, nN, nwg, G, c;
    __host__ __device__ void init(int M, int N, int G_, int c_) { nM = M / BM; nN = N / BM; nwg = nM * nN; G = G_; c = c_; }
    __host__ __device__ bool tile(long L, Unit& u) const {
        if (L >= nwg) return false;
        int wgid = (int)L; { const int q = nwg / NXCD, r = nwg % NXCD, xcd = wgid % NXCD, off = wgid / NXCD; wgid = (xcd < r ? xcd * (q + 1) : r * (q + 1) + (xcd - r) * q) + off; }
        const int nig = WGM * nN, gid = wgid / nig, fm = gid * WGM, gsz = (nM - fm) < WGM ? (nM - fm) : WGM;
        u.pm = fm + ((wgid % nig) % gsz); u.pn = (wgid % nig) / gsz; u.kofs = 0; return true;
    }
    __host__ __device__ bool next(int i, Unit& u) const { return tile((long)i * G + c, u); }
};
struct HalfOrder : StaticOrder {
    int khalf;
    __host__ __device__ bool next(int i, Unit& u) const { if (!tile((long)(i >> 1) * G + c, u)) return false; u.kofs = (i & 1) * khalf; return true; }
};

typedef float f32x2_t __attribute__((ext_vector_type(2)));
typedef __bf16 bf16x2_t __attribute__((ext_vector_type(2)));
__device__ __forceinline__ unsigned cvt_pk_bf16(float lo, float hi) { f32x2_t v = {lo, hi}; bf16x2_t b = __builtin_convertvector(v, bf16x2_t); return __builtin_bit_cast(unsigned, b); }
__device__ __forceinline__ u32x4 pack8(f32x4 a, f32x4 b) { u32x4 w; w.x = cvt_pk_bf16(a[0], a[1]); w.y = cvt_pk_bf16(a[2], a[3]); w.z = cvt_pk_bf16(b[0], b[1]); w.w = cvt_pk_bf16(b[2], b[3]); return w; }
__device__ __forceinline__ float bf_lo(unsigned w) { return __builtin_bit_cast(float, w << 16); }
__device__ __forceinline__ float bf_hi(unsigned w) { return __builtin_bit_cast(float, w & 0xffff0000u); }

template <class Epi, class Sched, bool ALIGN_EPI>
__device__ __forceinline__ void gemm_phase(PG8_LAS unsigned char* lds, const Gemm g, const Sched& S, const Epi& E) {
    const int tid = threadIdx.x, wid = __builtin_amdgcn_readfirstlane(tid >> 6), lane = tid & 63, wr = wid >> 2, wc = wid & 3, fr = lane & 15, fq = lane >> 4;
    const int nt = g.K / BK;
    unsigned voffA[2], voffB[2];
#pragma unroll
    for (int i = 0; i < 2; ++i) { int R, C; stage_rc(tid * 16 + i * 8192, R, C); const int Rb = Epi::PERM ? ((R & ~31) + perm32(R & 31)) : R;
        voffA[i] = (unsigned)(R * g.lda + C) * 2u; voffB[i] = (unsigned)(Rb * g.ldb + C) * 2u; }
    const size_t kstep = (size_t)(BK * 2);
    const size_t hstepA = (size_t)HALF * g.lda * 2, hstepB = (size_t)HALF * g.ldb * 2;
    const size_t tstepA = 2 * hstepA, tstepB = 2 * hstepB;
    const unsigned ldsw = (unsigned)wid * 1024u;
    const int aoff = lds_byte(wr * 64 + fr, fq * 8), boff = lds_byte(wc * 32 + fr, fq * 8);
#define PG8_SA(b, h) (((b) * 2 + (h)) * HTB)
#define PG8_SB(b, h) ((4 + (b) * 2 + (h)) * HTB)
#define PG8_STAGE(bufoff, gbase, voff) do { _Pragma("unroll") for (int _i = 0; _i < 2; ++_i) \
        __builtin_amdgcn_global_load_lds((const unsigned*)((const char*)(gbase) + (voff)[_i]), (PG8_LAS unsigned*)(lds + (bufoff) + ldsw + _i * 8192), 16, 0, 0); } while (0)
#define PG8_LDA(dst, b, h) do { _Pragma("unroll") for (int m = 0; m < 4; ++m) _Pragma("unroll") for (int k = 0; k < 2; ++k) dst[m][k] = *(const PG8_LAS bf16x8*)(lds + PG8_SA(b, h) + aoff + m * 2048 + k * 1024); } while (0)
#define PG8_LDB(dst, b, h) do { _Pragma("unroll") for (int n = 0; n < 2; ++n) _Pragma("unroll") for (int k = 0; k < 2; ++k) dst[n][k] = *(const PG8_LAS bf16x8*)(lds + PG8_SB(b, h) + boff + n * 2048 + k * 1024); } while (0)
#define PG8_MMA(ai, bj, At, Bt) do { __builtin_amdgcn_s_setprio(1); _Pragma("unroll") for (int m = 0; m < 4; ++m) _Pragma("unroll") for (int n = 0; n < 2; ++n) _Pragma("unroll") for (int k = 0; k < 2; ++k) \
        acc[ai][bj][m][n] = __builtin_amdgcn_mfma_f32_16x16x32_bf16(Bt[n][k], At[m][k], acc[ai][bj][m][n], 0, 0, 0); __builtin_amdgcn_s_setprio(0); } while (0)
#define PG8_WAIT_V(n) asm volatile("s_waitcnt vmcnt(" #n ")" ::: "memory")
#define PG8_WAIT_L(n) asm volatile("s_waitcnt lgkmcnt(" #n ")" ::: "memory")
#define PG8_BAR __builtin_amdgcn_s_barrier()
#define PG8_SCHED __builtin_amdgcn_sched_barrier(0)
    Unit cur, nxt; int ui = 0;
    if (!S.next(0, cur)) return;
    f32x4 acc[2][2][4][2];
#pragma unroll
    for (int a = 0; a < 2; ++a)
#pragma unroll
        for (int b = 0; b < 2; ++b)
#pragma unroll
            for (int m = 0; m < 4; ++m)
#pragma unroll
                for (int n = 0; n < 2; ++n) acc[a][b][m][n] = (f32x4){0.f, 0.f, 0.f, 0.f};
    bf16x8 At[4][2], B0[2][2], B1[2][2];
    const char* cA = (const char*)g.A + (size_t)cur.pm * tstepA + (size_t)cur.kofs * 2; const char* cB = (const char*)g.Bt + (size_t)cur.pn * tstepB + (size_t)cur.kofs * 2;
    PG8_STAGE(PG8_SB(0, 0), cB, voffB); PG8_STAGE(PG8_SB(0, 1), cB + hstepB, voffB); PG8_STAGE(PG8_SA(0, 0), cA, voffA); PG8_STAGE(PG8_SA(0, 1), cA + hstepA, voffA);
    if (wr == 1) PG8_BAR;
    PG8_WAIT_V(2); PG8_BAR;
    PG8_STAGE(PG8_SB(1, 0), cB + kstep, voffB); PG8_STAGE(PG8_SA(1, 0), cA + kstep, voffA); PG8_STAGE(PG8_SB(1, 1), cB + hstepB + kstep, voffB);
    PG8_WAIT_V(6); PG8_BAR;
    for (;;) {
        const bool has_next = S.next(ui + 1, nxt);
        const char* nA = has_next ? (const char*)g.A + (size_t)nxt.pm * tstepA + (size_t)nxt.kofs * 2 : cA; const char* nB = has_next ? (const char*)g.Bt + (size_t)nxt.pn * tstepB + (size_t)nxt.kofs * 2 : cB;
        for (int t = 0; t < nt; t += 2) {
            const bool last = (t == nt - 2);
            const char* a1 = cA + (size_t)(t + 1) * kstep;
            const char* a2 = last ? nA : cA + (size_t)(t + 2) * kstep; const char* b2 = last ? nB : cB + (size_t)(t + 2) * kstep;
            const char* a3 = a2 + kstep; const char* b3 = b2 + kstep;
            PG8_LDB(B0, 0, 0); PG8_LDB(B1, 0, 1); PG8_SCHED; PG8_LDA(At, 0, 0); PG8_STAGE(PG8_SA(1, 1), a1 + hstepA, voffA);
            PG8_WAIT_V(8); PG8_WAIT_L(0); PG8_BAR; PG8_MMA(0, 0, At, B0); PG8_MMA(0, 1, At, B1); PG8_BAR; PG8_SCHED;
            PG8_LDA(At, 0, 1); PG8_STAGE(PG8_SB(0, 0), b2, voffB); PG8_STAGE(PG8_SB(0, 1), b2 + hstepB, voffB); PG8_STAGE(PG8_SA(0, 0), a2, voffA);
            PG8_WAIT_V(8); PG8_WAIT_L(0); PG8_BAR; PG8_MMA(1, 0, At, B0); PG8_MMA(1, 1, At, B1); PG8_BAR; PG8_SCHED;
            PG8_LDB(B0, 1, 0); PG8_LDB(B1, 1, 1); PG8_SCHED; PG8_LDA(At, 1, 0); PG8_STAGE(PG8_SA(0, 1), a2 + hstepA, voffA);
            PG8_WAIT_V(8); PG8_WAIT_L(0); PG8_BAR; PG8_MMA(0, 0, At, B0); PG8_MMA(0, 1, At, B1); PG8_BAR; PG8_SCHED;
            PG8_LDA(At, 1, 1); PG8_STAGE(PG8_SB(1, 0), b3, voffB); PG8_STAGE(PG8_SB(1, 1), b3 + hstepB, voffB); PG8_STAGE(PG8_SA(1, 0), a3, voffA);
            PG8_WAIT_V(8); PG8_WAIT_L(0); PG8_BAR; PG8_MMA(1, 0, At, B0); PG8_MMA(1, 1, At, B1); PG8_BAR; PG8_SCHED;
        }
        if constexpr (ALIGN_EPI) { if (wr == 0) PG8_BAR; }
        if constexpr (!Epi::AFTER_DRAIN) { Unit ce = cur; asm volatile("" : "+s"(ce.pm), "+s"(ce.pn), "+s"(ce.kofs));
            E(acc, ce, wr, wc, fr, fq); }
        if (!has_next) break;
#pragma unroll
        for (int a = 0; a < 2; ++a)
#pragma unroll
            for (int b = 0; b < 2; ++b)
#pragma unroll
                for (int m = 0; m < 4; ++m)
#pragma unroll
                    for (int n = 0; n < 2; ++n) acc[a][b][m][n] = (f32x4){0.f, 0.f, 0.f, 0.f};
        cur = nxt; cA = nA; cB = nB; ++ui;
        if constexpr (ALIGN_EPI) { if (wr == 1) PG8_BAR; }
    }
    PG8_WAIT_V(0);
    if constexpr (!ALIGN_EPI) { if (wr == 0) PG8_BAR; }
    PG8_BAR;
    if constexpr (Epi::AFTER_DRAIN) { E.fused(acc, cur, wr, wc, fr, fq, lds, wid, lane); }
#undef PG8_SA
#undef PG8_SB
#undef PG8_STAGE
#undef PG8_LDA
#undef PG8_LDB
#undef PG8_MMA
#undef PG8_WAIT_V
#undef PG8_WAIT_L
#undef PG8_BAR
#undef PG8_SCHED
}
}
constexpr int BATCH = 4, SEQ = 2048, DM = 2048, MTOK = BATCH * SEQ, NH = 8, HD = 128, DFF = 5632, INC = 10248, NIN = 10240, WID = 1024;
constexpr float RMS_EPS = 1e-6f;
constexpr int NWAVES = 8, NTHREADS = 512;

constexpr size_t MiB = 1u << 20;
constexpr size_t WS_CTL = 0;
constexpr size_t WS_LOGF = 1 * MiB, WS_CUM = WS_LOGF + 256 * 1024;
constexpr size_t WS_COS = 2 * MiB, WS_SIN = WS_COS + 512 * 1024;
constexpr size_t WS_KPART = 3 * MiB;
constexpr size_t WS_SSQ1 = 3 * MiB + 512 * 1024, WS_SSQ2 = WS_SSQ1 + 256 * 1024;
constexpr size_t WS_WIN = 8 * MiB, WS_WO = 48 * MiB, WS_WOUT = 56 * MiB, WS_WGU = 64 * MiB, WS_WD = 108 * MiB;
constexpr size_t WS_B = 130 * MiB;
constexpr size_t WS_D = 162 * MiB;
constexpr size_t WS_HACT = WS_B;
constexpr size_t WS_C = 226 * MiB;
constexpr size_t WS_X1 = WS_C, WS_X1B = WS_C + 64 * MiB;
constexpr size_t WS_END = 322 * MiB;
constexpr size_t QKV_ELEMS = (size_t)MTOK * WID;

typedef unsigned short bf16;
typedef float f32x4 __attribute__((ext_vector_type(4)));
typedef unsigned u32x4 __attribute__((ext_vector_type(4)));
#define LAS __attribute__((address_space(3)))

using pg8::Unit; using pg8::pack8; using pg8::bf_lo; using pg8::bf_hi;
__device__ __forceinline__ float fast_sigmoid(float x) { return __builtin_amdgcn_rcpf(1.f + __builtin_amdgcn_exp2f(-1.4426950408889634f * x)); }

struct EpiIn {
    static constexpr bool PERM = true, AFTER_DRAIN = false;
    bf16* qkv; bf16* gates; const float* cosT; const float* sinT; float* kpart;
    __device__ __forceinline__ void operator()(const f32x4 (&acc)[2][2][4][2], const Unit& u, int wr, int wc, int fr, int fq) const {
        const int row0 = u.pm * 256 + wr * 64 + fr;
        if (u.pn >= 24) {
            bf16* gb_ = gates + (u.pn >= 32 ? (size_t)MTOK * DM : 0);
            const int col0 = ((u.pn - 24) & 7) * 256 + wc * 32 + 8 * fq;
#pragma unroll
            for (int ai = 0; ai < 2; ++ai)
#pragma unroll
                for (int m = 0; m < 4; ++m) { bf16* rowp = gb_ + (size_t)(row0 + ai * 128 + m * 16) * DM + col0;
#pragma unroll
                    for (int bj = 0; bj < 2; ++bj) { f32x4 v0 = acc[ai][bj][m][0], v1 = acc[ai][bj][m][1];
#pragma unroll
                        for (int e = 0; e < 4; ++e) { v0[e] = fast_sigmoid(v0[e]); v1[e] = fast_sigmoid(v1[e]); }
                        *(u32x4*)(rowp + bj * 128) = pack8(v0, v1); }
                    asm volatile("" ::: "memory"); }
            return;
        }
        const int t = u.pn >> 2;
        bf16* base = qkv + (size_t)t * QKV_ELEMS;
        if (t != 3 && t != 4) {
            const int d0 = wc * 32 + 8 * fq;
#pragma unroll
            for (int ai = 0; ai < 2; ++ai)
#pragma unroll
                for (int m = 0; m < 4; ++m) { const int row = row0 + ai * 128 + m * 16, b = row >> 11, s = row & 2047;
#pragma unroll
                    for (int bj = 0; bj < 2; ++bj) { const int h = (u.pn & 3) * 2 + bj;
                        *(u32x4*)(base + ((size_t)((b * NH + h) * SEQ + s)) * HD + d0) = pack8(acc[ai][bj][m][0], acc[ai][bj][m][1]); }
                    asm volatile("" ::: "memory"); }
            return;
        }
        const int h = (u.pn & 3) * 2 + (wc >> 1), d1 = 32 * (wc & 1) + 8 * fq;
        f32x4 ks[2][2];
#pragma unroll
        for (int bj = 0; bj < 2; ++bj)
#pragma unroll
            for (int n = 0; n < 2; ++n) ks[bj][n] = (f32x4){0.f, 0.f, 0.f, 0.f};
#pragma unroll
        for (int ai = 0; ai < 2; ++ai)
#pragma unroll
            for (int m = 0; m < 4; ++m) { const int row = row0 + ai * 128 + m * 16, b = row >> 11, s = row & 2047;
                const f32x4 c0 = *(const f32x4*)(cosT + s * 64 + d1), c1 = *(const f32x4*)(cosT + s * 64 + d1 + 4);
                const f32x4 s0 = *(const f32x4*)(sinT + s * 64 + d1), s1 = *(const f32x4*)(sinT + s * 64 + d1 + 4);
                const f32x4 a0 = acc[ai][0][m][0], a1 = acc[ai][0][m][1], b0 = acc[ai][1][m][0], b1 = acc[ai][1][m][1];
                const f32x4 o10 = a0 * c0 - b0 * s0, o11 = a1 * c1 - b1 * s1, o20 = b0 * c0 + a0 * s0, o21 = b1 * c1 + a1 * s1;
                bf16* dst = base + ((size_t)((b * NH + h) * SEQ + s)) * HD + d1;
                *(u32x4*)(dst) = pack8(o10, o11); *(u32x4*)(dst + 64) = pack8(o20, o21);
                ks[0][0] += o10; ks[0][1] += o11; ks[1][0] += o20; ks[1][1] += o21;
                asm volatile("" : "+v"(ks[0][0]), "+v"(ks[0][1]), "+v"(ks[1][0]), "+v"(ks[1][1]) :: "memory"); }
        if (t == 4) {
#pragma unroll
            for (int bj = 0; bj < 2; ++bj)
#pragma unroll
                for (int n = 0; n < 2; ++n)
#pragma unroll
                    for (int e = 0; e < 4; ++e) { float v = ks[bj][n][e]; v += __shfl_xor(v, 1); v += __shfl_xor(v, 2); v += __shfl_xor(v, 4); v += __shfl_xor(v, 8); ks[bj][n][e] = v; }
            if (fr == 0) { float* kp = kpart + (size_t)(u.pm * 2 + wr) * 1024 + h * 128 + d1;
                *(f32x4*)(kp) = ks[0][0]; *(f32x4*)(kp + 4) = ks[0][1]; *(f32x4*)(kp + 64) = ks[1][0]; *(f32x4*)(kp + 68) = ks[1][1]; }
        }
    }
};

struct EpiY {
    static constexpr bool PERM = true, AFTER_DRAIN = false;
    const bf16* ga; const bf16* gb; float* T; bf16* y;
    __device__ __forceinline__ void operator()(const f32x4 (&acc)[2][2][4][2], const Unit& u, int wr, int wc, int fr, int fq) const {
        const int row0 = u.pm * 256 + wr * 64 + fr, col0 = u.pn * 256 + wc * 32 + 8 * fq;
        const bool first = (u.kofs == 0);
        const bf16* gsrc = first ? ga : gb;
#pragma unroll
        for (int ai = 0; ai < 2; ++ai)
#pragma unroll
            for (int m = 0; m < 4; ++m) {
#pragma unroll
                for (int bj = 0; bj < 2; ++bj) { const size_t off = (size_t)(row0 + ai * 128 + m * 16) * DM + col0 + bj * 128;
                    const u32x4 gw = *(const u32x4*)(gsrc + off);
                    f32x4 g0 = {bf_lo(gw.x), bf_hi(gw.x), bf_lo(gw.y), bf_hi(gw.y)}, g1 = {bf_lo(gw.z), bf_hi(gw.z), bf_lo(gw.w), bf_hi(gw.w)};
                    f32x4 v0 = acc[ai][bj][m][0] * g0, v1 = acc[ai][bj][m][1] * g1;
                    if (first) { *(f32x4*)(T + off) = v0; *(f32x4*)(T + off + 4) = v1; }
                    else { v0 += *(const f32x4*)(T + off); v1 += *(const f32x4*)(T + off + 4); *(u32x4*)(y + off) = pack8(v0, v1); } }
                asm volatile("" ::: "memory"); }
    }
};

struct EpiRes {
    static constexpr bool PERM = true, AFTER_DRAIN = true;
    const float* base; float* out; bf16* outb; float* ssq;
    __device__ __forceinline__ void fused(f32x4 (&acc)[2][2][4][2], const Unit& u, int wr, int wc, int fr, int fq, PG8_LAS unsigned char* lds, int wid, int lane) const {
        PG8_LAS float* P = (PG8_LAS float*)lds;
        const int row0 = u.pm * 256 + wr * 64 + fr, col0 = u.pn * 256 + wc * 32 + 8 * fq;
#pragma unroll
        for (int ai = 0; ai < 2; ++ai)
#pragma unroll
            for (int m = 0; m < 4; ++m) { float ss = 0.f;
#pragma unroll
                for (int bj = 0; bj < 2; ++bj) { const size_t off = (size_t)(row0 + ai * 128 + m * 16) * DM + col0 + bj * 128;
                    const f32x4 v0 = acc[ai][bj][m][0] + *(const f32x4*)(base + off), v1 = acc[ai][bj][m][1] + *(const f32x4*)(base + off + 4);
                    *(f32x4*)(out + off) = v0; *(f32x4*)(out + off + 4) = v1;
                    if (outb) *(u32x4*)(outb + off) = pack8(v0, v1);
                    ss += (v0[0] * v0[0] + v0[1] * v0[1]) + (v0[2] * v0[2] + v0[3] * v0[3]) + (v1[0] * v1[0] + v1[1] * v1[1]) + (v1[2] * v1[2] + v1[3] * v1[3]); }
                ss += __shfl_xor(ss, 16); ss += __shfl_xor(ss, 32);
                if (fq == 0) P[(ai * 128 + wr * 64 + m * 16 + fr) * 4 + wc] = ss;
                asm volatile("" ::: "memory"); }
        asm volatile("s_waitcnt lgkmcnt(0)" ::: "memory"); __builtin_amdgcn_s_barrier(); asm volatile("" ::: "memory");
        const int tid = wid * 64 + lane;
        if (tid < 256) { const float s = (P[tid * 4 + 0] + P[tid * 4 + 1]) + (P[tid * 4 + 2] + P[tid * 4 + 3]); ssq[(size_t)(u.pm * 256 + tid) * 8 + u.pn] = s; }
    }
};

struct EpiGU {
    static constexpr bool PERM = true, AFTER_DRAIN = false;
    const float* ssq; bf16* hact;
    __device__ __forceinline__ void operator()(const f32x4 (&acc)[2][2][4][2], const Unit& u, int wr, int wc, int fr, int fq) const {
        const int row0 = u.pm * 256 + wr * 64 + fr, col0 = u.pn * 128 + wc * 32 + 8 * fq;
#pragma unroll
        for (int ai = 0; ai < 2; ++ai)
#pragma unroll
            for (int m = 0; m < 4; ++m) { const int row = row0 + ai * 128 + m * 16;
                const f32x4 p0 = *(const f32x4*)(ssq + (size_t)row * 8), p1 = *(const f32x4*)(ssq + (size_t)row * 8 + 4);
                const float tot = ((p0[0] + p0[1]) + (p0[2] + p0[3])) + ((p1[0] + p1[1]) + (p1[2] + p1[3]));
                const float rstd = __builtin_amdgcn_rsqf(tot * (1.f / DM) + RMS_EPS);
                f32x4 o[2];
#pragma unroll
                for (int n = 0; n < 2; ++n)
#pragma unroll
                    for (int e = 0; e < 4; ++e) { const float g = acc[ai][0][m][n][e] * rstd, up = acc[ai][1][m][n][e] * rstd; o[n][e] = g * fast_sigmoid(g) * up; }
                *(u32x4*)(hact + (size_t)row * DFF + col0) = pack8(o[0], o[1]); }
    }
};
constexpr int LDS_BYTES = 147456;
struct Args { const float* in[11]; float* out; unsigned char* ws; int ph_lo, ph_hi; };

__device__ __forceinline__ float wave_sum(float v) {
#pragma unroll
    for (int o = 1; o < 64; o <<= 1) v += __shfl_xor(v, o);
    return v;
}
__device__ __forceinline__ unsigned f2bf(float f) { unsigned u = __builtin_bit_cast(unsigned, f); return (u + 0x7fffu + ((u >> 16) & 1u)) >> 16; }
__device__ __forceinline__ unsigned pk2(float lo, float hi) { return f2bf(lo) | (f2bf(hi) << 16); }

__device__ __forceinline__ void tr_item(const float* W, int ldw, int k0, int n0, bf16* WT, int ldt, int drow0, int dk0, const float* gk, LAS float* scr, int lane) {
#pragma unroll 8
    for (int i = 0; i < 32; ++i) { const int kk = 2 * i + (lane >> 5); float v = W[(size_t)(k0 + kk) * ldw + n0 + (lane & 31)]; if (gk) v *= gk[k0 + kk]; scr[kk * 33 + (lane & 31)] = v; }
    asm volatile("s_waitcnt lgkmcnt(0)" ::: "memory");
    const int c = lane & 7;
#pragma unroll
    for (int j = 0; j < 4; ++j) { const int n = (lane >> 3) + 8 * j; const LAS float* s = scr + (8 * c) * 33 + n;
        u32x4 o; o.x = pk2(s[0 * 33], s[1 * 33]); o.y = pk2(s[2 * 33], s[3 * 33]); o.z = pk2(s[4 * 33], s[5 * 33]); o.w = pk2(s[6 * 33], s[7 * 33]);
        *(u32x4*)(WT + (size_t)(drow0 + n) * ldt + dk0 + 8 * c) = o; }
    asm volatile("s_waitcnt lgkmcnt(0)" ::: "memory");
}

__device__ __forceinline__ void p0_prologue(const Args& a, LAS unsigned char* lds, int G, int vcu) {
    const int tid = threadIdx.x, lane = tid & 63, wave = __builtin_amdgcn_readfirstlane(tid >> 6);
    const float* x = a.in[0]; const float* nmix = a.in[1]; const float* w_in = a.in[2]; const float* bfg = a.in[3];
    unsigned char* ws = a.ws;
    LAS float* wfT = (LAS float*)lds;
    LAS float* scr = (LAS float*)(lds + 65536 + wave * 8448);
    for (int i = tid; i < 8 * 2048; i += NTHREADS) { const int k = i >> 3, jj = i & 7; wfT[jj * 2048 + k] = w_in[(size_t)k * INC + 6144 + jj]; }
    { float* cosT = (float*)(ws + WS_COS); float* sinT = (float*)(ws + WS_SIN);
      for (int i = vcu * NTHREADS + tid; i < SEQ * 64; i += G * NTHREADS) { const int pos = i >> 6, f = i & 63;
          const float inv = powf(10000.f, -(float)f / 64.f); const float ang = (float)pos * inv; float s, c; sincosf(ang, &s, &c); cosT[i] = c; sinT[i] = s; } }
    __syncthreads();
    const int gw = vcu * NWAVES + wave, NGW = G * NWAVES;
    { bf16* h1 = (bf16*)(ws + WS_B); float* logf = (float*)(ws + WS_LOGF);
      for (int m = gw; m < MTOK; m += NGW) {
          const f32x4* xr = (const f32x4*)(x + (size_t)m * DM) + lane; const f32x4* g4 = (const f32x4*)nmix + lane;
          f32x4 v[8]; float ss = 0.f;
#pragma unroll
          for (int j = 0; j < 8; ++j) { v[j] = xr[64 * j]; ss += (v[j][0] * v[j][0] + v[j][1] * v[j][1]) + (v[j][2] * v[j][2] + v[j][3] * v[j][3]); }
          ss = wave_sum(ss); const float rstd = 1.f / sqrtf(ss * (1.f / DM) + RMS_EPS);
          float fa[8];
#pragma unroll
          for (int jj = 0; jj < 8; ++jj) fa[jj] = 0.f;
          unsigned long long* o8 = (unsigned long long*)(h1 + (size_t)m * DM) + lane;
#pragma unroll
          for (int j = 0; j < 8; ++j) { const f32x4 hv = v[j] * g4[64 * j]; asm volatile("" ::: "memory");
#pragma unroll
              for (int jj = 0; jj < 8; ++jj) { const f32x4 w4 = *(const LAS f32x4*)(wfT + jj * 2048 + 256 * j + 4 * lane); fa[jj] += (hv[0] * w4[0] + hv[1] * w4[1]) + (hv[2] * w4[2] + hv[3] * w4[3]); }
              o8[64 * j] = (unsigned long long)pk2(hv[0] * rstd, hv[1] * rstd) | ((unsigned long long)pk2(hv[2] * rstd, hv[3] * rstd) << 32); }
#pragma unroll
          for (int jj = 0; jj < 8; ++jj) fa[jj] = wave_sum(fa[jj]) * rstd;
          float z = fa[0];
#pragma unroll
          for (int jj = 1; jj < 8; ++jj) z = (lane == jj) ? fa[jj] : z;
          if (lane < 8) { z += bfg[lane]; const float ls = -(fmaxf(-z, 0.f) + log1pf(expf(-fabsf(z)))); logf[(size_t)((m >> 11) * NH + lane) * SEQ + (m & 2047)] = ls; }
      } }
    constexpr int I_IN = 32 * 320, I_OF = 16 * 64, I_OM = 16 * 64, I_OUT = 32 * 64, I_GU = 32 * 352, I_D = 88 * 64;
    constexpr int NITEMS = I_IN + I_OF + I_OM + I_OUT + I_GU + I_D;
    for (int it = gw; it < NITEMS; it += NGW) {
        int r = it;
        if (r < I_IN) { const int kb = r / 320, ng = r % 320, dr = 32 * ng, pn = dr >> 8; int src;
            if (pn >= 12 && pn < 20) { const int slot = dr & 255, bj = slot >> 7, wc = (slot >> 5) & 3; src = (pn < 16 ? 3072 : 4096) + ((pn & 3) * 2 + (wc >> 1)) * 128 + 64 * bj + 32 * (wc & 1); }
            else src = dr < 6144 ? dr : dr + 8;
            tr_item(w_in, INC, 64 * kb, src, (bf16*)(ws + WS_WIN), DM, dr, 64 * kb, nullptr, scr, lane); continue; } r -= I_IN;
        if (r < I_OF) { const int kb = r / 64, ng = r % 64; tr_item(a.in[4], DM, 64 * kb, 32 * ng, (bf16*)(ws + WS_WO), 2048, 32 * ng, 64 * kb, nullptr, scr, lane); continue; } r -= I_OF;
        if (r < I_OM) { const int kb = r / 64, ng = r % 64; tr_item(a.in[5], DM, 64 * kb, 32 * ng, (bf16*)(ws + WS_WO), 2048, 32 * ng, 1024 + 64 * kb, nullptr, scr, lane); continue; } r -= I_OM;
        if (r < I_OUT) { const int kb = r / 64, ng = r % 64; tr_item(a.in[6], DM, 64 * kb, 32 * ng, (bf16*)(ws + WS_WOUT), DM, 32 * ng, 64 * kb, nullptr, scr, lane); continue; } r -= I_OUT;
        if (r < I_GU) { const int kb = r / 352, ng = r % 352, dr = 32 * ng, pn = dr >> 8, slot = dr & 255, bj = slot >> 7, s = slot & 127;
            tr_item(a.in[8], 2 * DFF, 64 * kb, bj * DFF + pn * 128 + s, (bf16*)(ws + WS_WGU), DM, dr, 64 * kb, a.in[7], scr, lane); continue; } r -= I_GU;
        { const int kb = r / 64, ng = r % 64; tr_item(a.in[9], DM, 64 * kb, 32 * ng, (bf16*)(ws + WS_WD), DFF, 32 * ng, 64 * kb, nullptr, scr, lane); }
    }
}

__device__ __forceinline__ void final_norm(const Args& a, int G, int vcu) {
    const int tid = threadIdx.x, lane = tid & 63, wave = __builtin_amdgcn_readfirstlane(tid >> 6);
    const int gw = vcu * NWAVES + wave, NGW = G * NWAVES;
    const f32x4* g4 = (const f32x4*)a.in[10] + lane;
    for (int m = gw; m < MTOK; m += NGW) {
        f32x4* xr = (f32x4*)(a.out + (size_t)m * DM) + lane;
        f32x4 v[8]; float ss = 0.f;
#pragma unroll
        for (int j = 0; j < 8; ++j) { v[j] = xr[64 * j]; ss += (v[j][0] * v[j][0] + v[j][1] * v[j][1]) + (v[j][2] * v[j][2] + v[j][3] * v[j][3]); }
        ss = wave_sum(ss); const float rstd = 1.f / sqrtf(ss * (1.f / DM) + RMS_EPS);
#pragma unroll
        for (int j = 0; j < 8; ++j) xr[64 * j] = v[j] * rstd * g4[64 * j];
    }
}

__global__ void scan_naive(const float* logf, float* cum) {
    const int i = blockIdx.x * blockDim.x + threadIdx.x; if (i >= BATCH * NH) return;
    float c = 0.f; for (int s = 0; s < SEQ; ++s) { c += logf[(size_t)i * SEQ + s]; cum[(size_t)i * SEQ + s] = c; }
}
__device__ __forceinline__ float wave_max(float v) {
#pragma unroll
    for (int o = 1; o < 64; o <<= 1) v = fmaxf(v, __shfl_xor(v, o));
    return v;
}
template <int MODE>
__global__ void __launch_bounds__(256) attn_naive(const bf16* Q, const bf16* K, const bf16* V, const float* cum, const float* kpart, bf16* O) {
    __shared__ float sc[4][2048]; __shared__ float qs[4][128];
    const int lane = threadIdx.x & 63, w = threadIdx.x >> 6;
    const int idx = blockIdx.x * 4 + w, bh = idx >> 11, t = idx & 2047, b = bh >> 3, h = bh & 7;
    const bf16* q = Q + ((size_t)bh * SEQ + t) * HD; const bf16* kb = K + (size_t)bh * SEQ * HD; const bf16* vb = V + (size_t)bh * SEQ * HD;
    { const unsigned qw = *(const unsigned*)(q + 2 * lane); qs[w][2 * lane] = pg8::bf_lo(qw); qs[w][2 * lane + 1] = pg8::bf_hi(qw); }
    __syncthreads();
    const float scale = 0.08838834764831845f;
    const int blk = t >> 8;
    unsigned sel = (1u << blk) - 1u;
    if (MODE == 1 && blk > 3) {
        float g = -__builtin_inff();
        if (lane < blk) { const float* k0 = kpart + (size_t)((b * 8 + lane) * 2) * 1024 + h * 128; float acc = 0.f;
            for (int d = 0; d < 128; ++d) acc += qs[w][d] * ((k0[d] + k0[1024 + d]) * (1.f / 256.f)); g = acc; }
        int rank = 0;
        for (int mm = 0; mm < 8; ++mm) { const float gm = __shfl(g, mm); if (mm < blk && (gm > g || (gm == g && mm < lane))) ++rank; }
        const unsigned long long bal = __ballot(lane < blk && rank < 3);
        sel = (unsigned)bal;
    }
    const float ct = (MODE == 0) ? cum[(size_t)bh * SEQ + t] : 0.f;
    float mx = -__builtin_inff();
    for (int k0 = 0; k0 <= t; k0 += 64) {
        const int kblk = k0 >> 8;
        if (MODE == 1 && kblk != blk && !((sel >> kblk) & 1u)) { sc[w][k0 + lane] = -__builtin_inff(); continue; }
        const int key = k0 + lane; float s = -__builtin_inff();
        if (key <= t) { const u32x4* kr = (const u32x4*)(kb + (size_t)key * HD); float acc = 0.f;
#pragma unroll 4
            for (int c = 0; c < 16; ++c) { const u32x4 kw = kr[c]; const float* qq = &qs[w][8 * c];
                acc += qq[0] * pg8::bf_lo(kw.x) + qq[1] * pg8::bf_hi(kw.x) + qq[2] * pg8::bf_lo(kw.y) + qq[3] * pg8::bf_hi(kw.y) + qq[4] * pg8::bf_lo(kw.z) + qq[5] * pg8::bf_hi(kw.z) + qq[6] * pg8::bf_lo(kw.w) + qq[7] * pg8::bf_hi(kw.w); }
            s = acc * scale; if (MODE == 0) s += ct - cum[(size_t)bh * SEQ + key]; }
        sc[w][key] = s; mx = fmaxf(mx, s);
    }
    mx = wave_max(mx);
    float sum = 0.f;
    const int kend = (t | 63) + 1;
    for (int key = lane; key < kend; key += 64) { const float s = sc[w][key]; const float p = (s == -__builtin_inff()) ? 0.f : __expf(s - mx); sc[w][key] = p; sum += p; }
    sum = wave_sum(sum);
    __syncthreads();
    float o0 = 0.f, o1 = 0.f;
    for (int k0 = 0; k0 <= t; k0 += 64) {
        const int kblk = k0 >> 8;
        if (MODE == 1 && kblk != blk && !((sel >> kblk) & 1u)) continue;
        const int ke = (k0 + 64 <= t + 1) ? 64 : (t + 1 - k0);
        for (int j = 0; j < ke; ++j) { const float p = sc[w][k0 + j]; const unsigned vw = *(const unsigned*)(vb + (size_t)(k0 + j) * HD + 2 * lane); o0 += p * pg8::bf_lo(vw); o1 += p * pg8::bf_hi(vw); }
    }
    const float inv = 1.f / sum;
    *(unsigned*)(O + (size_t)(b * SEQ + t) * DM + h * HD + 2 * lane) = pk2(o0 * inv, o1 * inv);
}

__global__ void __launch_bounds__(NTHREADS, 2) mega(Args a) {
    extern __shared__ __attribute__((aligned(16))) unsigned char lds_raw[];
    LAS unsigned char* lds = (LAS unsigned char*)lds_raw;
    cg::grid_group grid = cg::this_grid();
    const int G = gridDim.x, bx = blockIdx.x, vcu = (G % 8 == 0) ? (bx % 8) * (G / 8) + bx / 8 : bx;
    unsigned char* ws = a.ws;
    const int lo = a.ph_lo, hi = a.ph_hi;
#define IN(k) (lo <= (k) && (k) < hi)
#define SEAM(k) do { if (IN(k) && IN((k) + 1)) grid.sync(); } while (0)
    if (IN(0)) { p0_prologue(a, lds, G, vcu); }
    SEAM(0);
    if (IN(1)) {
        pg8::Gemm g{(const bf16*)(ws + WS_B), (const bf16*)(ws + WS_WIN), DM, DM, DM}; pg8::StaticOrder S; S.init(MTOK, NIN, G, bx);
        EpiIn E{(bf16*)(ws + WS_C), (bf16*)(ws + WS_D), (const float*)(ws + WS_COS), (const float*)(ws + WS_SIN), (float*)(ws + WS_KPART)};
        pg8::gemm_phase<EpiIn, pg8::StaticOrder, true>(lds, g, S, E);
    }
    SEAM(1);
    SEAM(2);
    if (IN(3)) {
        pg8::Gemm g{(const bf16*)(ws + WS_B), (const bf16*)(ws + WS_WO), DM, DM, WID}; pg8::HalfOrder S; S.init(MTOK, DM, G, bx); S.khalf = WID;
        EpiY E{(const bf16*)(ws + WS_D), (const bf16*)(ws + WS_D + 32 * MiB), (float*)(ws + WS_X1), (bf16*)(ws + WS_D)};
        pg8::gemm_phase<EpiY, pg8::HalfOrder, true>(lds, g, S, E);
    }
    SEAM(3);
    if (IN(4)) {
        pg8::Gemm g{(const bf16*)(ws + WS_D), (const bf16*)(ws + WS_WOUT), DM, DM, DM}; pg8::StaticOrder S; S.init(MTOK, DM, G, bx);
        EpiRes E{a.in[0], (float*)(ws + WS_X1), (bf16*)(ws + WS_X1B), (float*)(ws + WS_SSQ1)};
        pg8::gemm_phase<EpiRes, pg8::StaticOrder, false>(lds, g, S, E);
    }
    SEAM(4);
    if (IN(5)) {
        pg8::Gemm g{(const bf16*)(ws + WS_X1B), (const bf16*)(ws + WS_WGU), DM, DM, DM}; pg8::StaticOrder S; S.init(MTOK, 2 * DFF, G, bx);
        EpiGU E{(const float*)(ws + WS_SSQ1), (bf16*)(ws + WS_HACT)};
        pg8::gemm_phase<EpiGU, pg8::StaticOrder, true>(lds, g, S, E);
    }
    SEAM(5);
    if (IN(6)) {
        pg8::Gemm g{(const bf16*)(ws + WS_HACT), (const bf16*)(ws + WS_WD), DFF, DFF, DFF}; pg8::StaticOrder S; S.init(MTOK, DM, G, bx);
        EpiRes E{(const float*)(ws + WS_X1), a.out, nullptr, (float*)(ws + WS_SSQ2)};
        pg8::gemm_phase<EpiRes, pg8::StaticOrder, false>(lds, g, S, E);
    }
    SEAM(6);
    if (IN(7)) { final_norm(a, G, vcu); }
#undef IN
#undef SEAM
}

#ifdef DEBUG_CHECKS
constexpr size_t WS_DBG = 4 * MiB;
__device__ __forceinline__ float bf2f(bf16 v) { return __builtin_bit_cast(float, (unsigned)v << 16); }
__device__ __forceinline__ void dbg_record(float* dbg, int k, float got, float ref, float floor_) {
    float e = fabsf(got - ref) / (fabsf(ref) + floor_); if (!(e == e)) e = 1e9f;
    atomicMax((int*)(dbg + k), __float_as_int(e));
}
__device__ __forceinline__ float block_sum256(float v, float* red) {
    v = wave_sum(v); __syncthreads(); if ((threadIdx.x & 63) == 0) red[threadIdx.x >> 6] = v; __syncthreads();
    return red[0] + red[1] + red[2] + red[3];
}
__device__ __forceinline__ unsigned hash_u(unsigned x) { x ^= x >> 16; x *= 0x7feb352du; x ^= x >> 15; x *= 0x846ca68bu; x ^= x >> 16; return x; }

__global__ void chk_p0(Args a, float* dbg) {
    __shared__ float red[4];
    const int m = hash_u(blockIdx.x * 7919u + 13u) % MTOK; const float* x = a.in[0] + (size_t)m * DM;
    float ss = 0.f; for (int k = threadIdx.x; k < DM; k += 256) ss += x[k] * x[k];
    ss = block_sum256(ss, red); const float rstd = 1.f / sqrtf(ss / DM + RMS_EPS);
    const bf16* h1 = (const bf16*)(a.ws + WS_B) + (size_t)m * DM;
    for (int k = threadIdx.x; k < DM; k += 256) dbg_record(dbg, 0, bf2f(h1[k]), x[k] * rstd * a.in[1][k], 0.02f);
    for (int h = 0; h < 8; ++h) { float acc = 0.f; for (int k = threadIdx.x; k < DM; k += 256) acc += x[k] * rstd * a.in[1][k] * a.in[2][(size_t)k * INC + 6144 + h];
        acc = block_sum256(acc, red); const float z = acc + a.in[3][h]; const float ref = z < 0.f ? z - log1pf(expf(z)) : -log1pf(expf(-z));
        if (threadIdx.x == 0) dbg_record(dbg, 1, ((const float*)(a.ws + WS_LOGF))[(size_t)((m >> 11) * NH + h) * SEQ + (m & 2047)], ref, 0.01f); }
}
__global__ void chk_in(Args a, float* dbg) {
    __shared__ float red[4];
    const unsigned hs = hash_u(blockIdx.x * 2654435761u + 99u);
    const int grp = blockIdx.x % 8, m = hs % MTOK, b = m >> 11, s = m & 2047;
    const bf16* h1 = (const bf16*)(a.ws + WS_B) + (size_t)m * DM; const float* w = a.in[2];
    const bf16* qkv = (const bf16*)(a.ws + WS_C);
    if (grp < 6) {
        const int h = (hs >> 13) % 8, d = (hs >> 17) % 64;
        const int c1 = grp * 1024 + h * 128 + d, c2 = c1 + 64;
        float a1 = 0.f, a2 = 0.f; for (int k = threadIdx.x; k < DM; k += 256) { const float hv = bf2f(h1[k]); a1 += hv * w[(size_t)k * INC + c1]; a2 += hv * w[(size_t)k * INC + c2]; }
        a1 = block_sum256(a1, red); a2 = block_sum256(a2, red);
        float r1 = a1, r2 = a2;
        if (grp == 3 || grp == 4) { const float inv = powf(10000.f, -(float)d / 64.f), ang = (float)s * inv; const float cs = cosf(ang), sn = sinf(ang); r1 = a1 * cs - a2 * sn; r2 = a2 * cs + a1 * sn; }
        if (threadIdx.x == 0) { const bf16* p = qkv + (size_t)grp * QKV_ELEMS + ((size_t)((b * NH + h) * SEQ + s)) * HD;
            dbg_record(dbg, 2 + grp, bf2f(p[d]), r1, 0.5f); dbg_record(dbg, 2 + grp, bf2f(p[d + 64]), r2, 0.5f);
            const bool rot = (grp == 3 || grp == 4);
            if (((m >> 7) & 1) && (rot ? h >= 6 : h == 7)) dbg_record(dbg, 40 + grp, bf2f(p[d + 64]), r2, 0.05f); }
    } else {
        const int n = (hs >> 13) % 2048, c = (grp == 6 ? 6152 : 8200) + n;
        float a1 = 0.f; for (int k = threadIdx.x; k < DM; k += 256) a1 += bf2f(h1[k]) * w[(size_t)k * INC + c];
        a1 = block_sum256(a1, red);
        float am = 0.f, ap = 0.f; for (int k = threadIdx.x; k < DM; k += 256) { am += bf2f(h1[k]) * w[(size_t)k * INC + c - 8]; ap += bf2f(h1[k]) * w[(size_t)k * INC + (c + 8 < INC ? c + 8 : c)]; }
        am = block_sum256(am, red); ap = block_sum256(ap, red);
        if (threadIdx.x == 0) { const bf16* g = (const bf16*)(a.ws + WS_D) + (grp == 7 ? (size_t)MTOK * DM : 0) + (size_t)m * DM + n; const float got = bf2f(*g); dbg_record(dbg, 2 + grp, got, 1.f / (1.f + expf(-a1)), 0.1f);
            if (grp == 6) { dbg_record(dbg, 21, got, 1.f / (1.f + expf(-am)), 0.02f); dbg_record(dbg, 22, got, 1.f / (1.f + expf(-ap)), 0.02f); dbg_record(dbg, 23, got, 1.f / (1.f + expf(a1)), 0.02f); dbg_record(dbg, 24, got, a1, 0.02f);
                const float g2 = bf2f(g[(size_t)MTOK * DM]); dbg_record(dbg, 25, g2, 1.f / (1.f + expf(-a1)), 0.02f);
                const int tile_par = (n >> 8) & 1; dbg_record(dbg, 26 + tile_par, got, 1.f / (1.f + expf(-a1)), 0.02f);
                dbg_record(dbg, 28 + ((n >> 7) & 1), got, 1.f / (1.f + expf(-a1)), 0.02f);
                dbg_record(dbg, 30 + ((m >> 7) & 1), got, 1.f / (1.f + expf(-a1)), 0.02f);
                if (((n >> 8) & 1) && ((n >> 7) & 1) && ((m >> 7) & 1)) { dbg_record(dbg, 32 + (n >> 9), got, 1.f / (1.f + expf(-a1)), 0.02f);
                    dbg_record(dbg, 36 + (((m >> 8) & 7) >> 2), got, 1.f / (1.f + expf(-a1)), 0.02f); } } }
    }
}
__global__ void chk_kpart(Args a, float* dbg) {
    const unsigned hs = hash_u(blockIdx.x * 40503u + 7u); const int pm = hs % 32, h = (hs >> 8) % 8, d = threadIdx.x & 127, b = pm >> 3, blk = pm & 7;
    if (threadIdx.x >= 128) return;
    const bf16* kb = (const bf16*)(a.ws + WS_C) + 4 * QKV_ELEMS + ((size_t)((b * NH + h) * SEQ + blk * 256)) * HD;
    float acc = 0.f; for (int r = 0; r < 256; ++r) acc += bf2f(kb[(size_t)r * HD + d]);
    const float* kp = (const float*)(a.ws + WS_KPART) + (size_t)(pm * 2) * 1024 + h * 128 + d;
    dbg_record(dbg, 10, kp[0] + kp[1024], acc, 4.0f);
}
__global__ void chk_attn(Args a, float* dbg, float* scratch  ) {
    const int id = blockIdx.x * blockDim.x + threadIdx.x; const int mode = id & 1;
    const unsigned hs = hash_u(id * 97u + 5u); const int b = hs % 4, h = (hs >> 4) % 8; int t = (hs >> 8) % 2048; if ((id >> 1) % 4 == 0) t = 1024 + (t % 1024);
    const bf16* base = (const bf16*)(a.ws + WS_C) + (size_t)(mode * 3) * QKV_ELEMS;
    const bf16* q = base + ((size_t)((b * NH + h) * SEQ + t)) * HD; const bf16* K = base + QKV_ELEMS + (size_t)(b * NH + h) * SEQ * HD; const bf16* V = base + 2 * QKV_ELEMS + (size_t)(b * NH + h) * SEQ * HD;
    float* lg = scratch + (size_t)id * 2048;
    const int blk = t >> 8; unsigned selm = (1u << blk) - 1u;
    if (mode == 1 && blk > 3) { float g[8];
#pragma unroll
        for (int n = 0; n < 8; ++n) { float acc = 0.f; const float* kp = (const float*)(a.ws + WS_KPART) + (size_t)((b * 8 + n) * 2) * 1024 + h * 128;
            if (n < blk) for (int d = 0; d < 128; ++d) acc += bf2f(q[d]) * ((kp[d] + kp[1024 + d]) / 256.f); g[n] = acc; }
        selm = 0u;
#pragma unroll
        for (int n = 0; n < 8; ++n) { int rank = 0;
#pragma unroll
            for (int mm = 0; mm < 8; ++mm) if (mm < blk && (g[mm] > g[n] || (g[mm] == g[n] && mm < n))) ++rank;
            if (n < blk && rank < 3) selm |= 1u << n; } }
    const float* logf = (const float*)(a.ws + WS_LOGF) + (size_t)(b * NH + h) * SEQ;
    float ct = 0.f; if (mode == 0) for (int s = 0; s <= t; ++s) ct += logf[s];
    float cs = 0.f, mx = -1e30f;
    for (int s = 0; s <= t; ++s) { if (mode == 0) cs += logf[s];
        bool ok = (mode == 0) || (s >> 8) == blk || ((selm >> (s >> 8)) & 1u);
        float acc = 0.f; if (ok) for (int d = 0; d < 128; ++d) acc += bf2f(q[d]) * bf2f(K[(size_t)s * HD + d]);
        float l = ok ? acc * 0.08838834764831845f + (mode == 0 ? ct - cs : 0.f) : -1e30f; lg[s] = l; mx = fmaxf(mx, l); }
    float sum = 0.f; for (int s = 0; s <= t; ++s) { const float p = lg[s] < -1e29f ? 0.f : expf(lg[s] - mx); lg[s] = p; sum += p; }
    const bf16* O = (const bf16*)(a.ws + WS_B) + (size_t)(b * SEQ + t) * DM + mode * WID + h * HD;
    for (int d = 0; d < 128; d += 9) { float acc = 0.f; for (int s = 0; s <= t; ++s) acc += lg[s] * bf2f(V[(size_t)s * HD + d]); dbg_record(dbg, 11 + mode, bf2f(O[d]), acc / sum, 0.02f); }
}
__global__ void chk_y(Args a, float* dbg, float* yref, int phase) {
    __shared__ float red[4];
    const unsigned hs = hash_u(blockIdx.x * 31337u + 3u); const int m = hs % MTOK, n = (hs >> 13) % DM;
    if (phase == 0) { const bf16* o = (const bf16*)(a.ws + WS_B) + (size_t)m * DM; float a1 = 0.f, a2 = 0.f;
        for (int k = threadIdx.x; k < WID; k += 256) { a1 += bf2f(o[k]) * a.in[4][(size_t)k * DM + n]; a2 += bf2f(o[WID + k]) * a.in[5][(size_t)k * DM + n]; }
        a1 = block_sum256(a1, red); a2 = block_sum256(a2, red);
        if (threadIdx.x == 0) { const bf16* ga = (const bf16*)(a.ws + WS_D) + (size_t)m * DM + n; yref[blockIdx.x] = bf2f(ga[0]) * a1 + bf2f(ga[(size_t)MTOK * DM]) * a2; } }
    else if (threadIdx.x == 0) dbg_record(dbg, 13, bf2f(((const bf16*)(a.ws + WS_D))[(size_t)m * DM + n]), yref[blockIdx.x], 0.02f);
}
__global__ void chk_x1(Args a, float* dbg) {
    __shared__ float red[4];
    const unsigned hs = hash_u(blockIdx.x * 1299709u + 17u); const int m = hs % MTOK, n = (hs >> 13) % DM;
    const bf16* y = (const bf16*)(a.ws + WS_D) + (size_t)m * DM; float a1 = 0.f;
    for (int k = threadIdx.x; k < DM; k += 256) a1 += bf2f(y[k]) * a.in[6][(size_t)k * DM + n];
    a1 = block_sum256(a1, red);
    const float* x1 = (const float*)(a.ws + WS_X1) + (size_t)m * DM;
    float ss = 0.f; for (int k = threadIdx.x; k < DM; k += 256) ss += x1[k] * x1[k]; ss = block_sum256(ss, red);
    if (threadIdx.x == 0) { dbg_record(dbg, 14, x1[n], a.in[0][(size_t)m * DM + n] + a1, 0.05f); dbg_record(dbg, 15, bf2f(((const bf16*)(a.ws + WS_X1B))[(size_t)m * DM + n]), x1[n], 0.05f);
        const float* sq = (const float*)(a.ws + WS_SSQ1) + (size_t)m * 8; float tot = 0.f; for (int i = 0; i < 8; ++i) tot += sq[i]; dbg_record(dbg, 16, tot, ss, 1.f); }
}
__global__ void chk_hact(Args a, float* dbg) {
    __shared__ float red[4];
    const unsigned hs = hash_u(blockIdx.x * 15485863u + 29u); const int m = hs % MTOK, j = (hs >> 13) % DFF;
    const float* x1 = (const float*)(a.ws + WS_X1) + (size_t)m * DM;
    float ss = 0.f; for (int k = threadIdx.x; k < DM; k += 256) ss += x1[k] * x1[k]; ss = block_sum256(ss, red); const float rstd = 1.f / sqrtf(ss / DM + RMS_EPS);
    float g = 0.f, u = 0.f; for (int k = threadIdx.x; k < DM; k += 256) { const float hv = x1[k] * rstd * a.in[7][k]; g += hv * a.in[8][(size_t)k * 2 * DFF + j]; u += hv * a.in[8][(size_t)k * 2 * DFF + DFF + j]; }
    g = block_sum256(g, red); u = block_sum256(u, red);
    if (threadIdx.x == 0) dbg_record(dbg, 17, bf2f(((const bf16*)(a.ws + WS_HACT))[(size_t)m * DFF + j]), g / (1.f + expf(-g)) * u, 0.02f);
}
__global__ void chk_x2(Args a, float* dbg) {
    __shared__ float red[4];
    const unsigned hs = hash_u(blockIdx.x * 32452843u + 31u); const int m = hs % MTOK, n = (hs >> 13) % DM;
    const bf16* hct = (const bf16*)(a.ws + WS_HACT) + (size_t)m * DFF; float a1 = 0.f;
    for (int k = threadIdx.x; k < DFF; k += 256) a1 += bf2f(hct[k]) * a.in[9][(size_t)k * DM + n];
    a1 = block_sum256(a1, red);
    if (threadIdx.x == 0) dbg_record(dbg, 18, a.out[(size_t)m * DM + n], ((const float*)(a.ws + WS_X1))[(size_t)m * DM + n] + a1, 0.05f);
}
__global__ void chk_w(Args a, float* dbg) {
    const unsigned hs = hash_u((blockIdx.x * 256 + threadIdx.x) * 2246822519u + 41u); const int k = hs % DM; const int sel = (hs >> 11) & 1;
    const int n = sel ? 6144 + ((hs >> 12) % 4096) : ((hs >> 12) % 3072);
    const float ref = a.in[2][(size_t)k * INC + (sel ? n + 8 : n)];
    dbg_record(dbg, sel ? 19 : 20, bf2f(((const bf16*)(a.ws + WS_WIN))[(size_t)n * DM + k]), ref, 0.002f);
}
__global__ void dbg_zero(float* dbg) { if (threadIdx.x < 64) dbg[threadIdx.x] = 0.f; }
__global__ void dbg_clear(float* out) { const size_t i = (size_t)blockIdx.x * blockDim.x + threadIdx.x; if (i < (size_t)MTOK * DM) out[i] = 0.f; }
__global__ void dbg_apply(const float* dbg, float* out, int only, float tol) {
    if (threadIdx.x != 0) return;
    if (only == 99 || only == 98 || only == 97 || only == 96) { float code = 0.f; const int k0 = only == 99 ? 21 : (only == 98 ? 26 : (only == 97 ? 32 : 40)); for (int k = k0; k < k0 + 6; ++k) if (dbg[k] < tol) code = code * 2.f + 1.f; else code = code * 2.f; out[0] += 1000.f * (code + 1.f); return; }
    if (only >= 100) { out[0] += 1e4f * dbg[only - 100]; return; }
    for (int k = 0; k < 21; ++k) if ((only < 0 || only == k) && dbg[k] > tol) { out[0] += 1000.f * (k + 1); return; }
}
#endif
extern "C" void kernel_launch(void* const* d_in, const int* in_sizes, int n_in, void* d_out, int out_size, void* d_ws, size_t ws_size, hipStream_t stream) {
    static int grid = 0;
    if (grid == 0) {
        if (n_in != 11 || out_size != MTOK * DM || ws_size < WS_END) { fprintf(stderr, "kernel_launch: unexpected shapes (n_in %d out %d ws %zu)\n", n_in, out_size, ws_size); grid = -1; return; }
        int dev = 0, cus = 0;
        if (hipGetDevice(&dev) != hipSuccess || hipDeviceGetAttribute(&cus, hipDeviceAttributeMultiprocessorCount, dev) != hipSuccess) { grid = -1; return; }
        if (hipFuncSetAttribute((const void*)mega, hipFuncAttributeMaxDynamicSharedMemorySize, LDS_BYTES) != hipSuccess) { fprintf(stderr, "kernel_launch: hipFuncSetAttribute failed\n"); grid = -1; return; }
        grid = cus;
        if (grid != 256) { fprintf(stderr, "kernel_launch: built for 256 CUs, got %d\n", grid); grid = -1; return; }
    }
    if (grid < 0) return;
    Args a{};
    for (int i = 0; i < 11; ++i) a.in[i] = (const float*)d_in[i];
    a.out = (float*)d_out; a.ws = (unsigned char*)d_ws;
    unsigned char* ws = (unsigned char*)d_ws;
    auto run = [&](int lo, int hi) { a.ph_lo = lo; a.ph_hi = hi; hipLaunchKernelGGL(mega, dim3(grid), dim3(NTHREADS), LDS_BYTES, stream, a); };
    const bf16* qkv = (const bf16*)(ws + WS_C);
    auto attn = [&]() {
        hipLaunchKernelGGL(scan_naive, dim3(1), dim3(32), 0, stream, (const float*)(ws + WS_LOGF), (float*)(ws + WS_CUM));
        hipLaunchKernelGGL(attn_naive<0>, dim3(BATCH * NH * SEQ / 4), dim3(256), 0, stream, qkv, qkv + QKV_ELEMS, qkv + 2 * QKV_ELEMS, (const float*)(ws + WS_CUM), (const float*)(ws + WS_KPART), (bf16*)(ws + WS_B));
        hipLaunchKernelGGL(attn_naive<1>, dim3(BATCH * NH * SEQ / 4), dim3(256), 0, stream, qkv + 3 * QKV_ELEMS, qkv + 4 * QKV_ELEMS, qkv + 5 * QKV_ELEMS, (const float*)(ws + WS_CUM), (const float*)(ws + WS_KPART), (bf16*)(ws + WS_B) + WID);
    };
#ifdef DEBUG_CHECKS
    float* dbg = (float*)(ws + WS_DBG); float* yref = dbg + 64; float* scr = (float*)(ws + WS_DBG + 65536);
    hipLaunchKernelGGL(dbg_zero, dim3(1), dim3(64), 0, stream, dbg);
    run(0, 1); hipLaunchKernelGGL(chk_p0, dim3(64), dim3(256), 0, stream, a, dbg); hipLaunchKernelGGL(chk_w, dim3(64), dim3(256), 0, stream, a, dbg);
    run(1, 2); hipLaunchKernelGGL(chk_in, dim3(8192), dim3(256), 0, stream, a, dbg); hipLaunchKernelGGL(chk_kpart, dim3(64), dim3(256), 0, stream, a, dbg);
    attn(); hipLaunchKernelGGL(chk_attn, dim3(2), dim3(64), 0, stream, a, dbg, scr);
    hipLaunchKernelGGL(chk_y, dim3(256), dim3(256), 0, stream, a, dbg, yref, 0); run(3, 4); hipLaunchKernelGGL(chk_y, dim3(256), dim3(256), 0, stream, a, dbg, yref, 1);
    run(4, 5); hipLaunchKernelGGL(chk_x1, dim3(256), dim3(256), 0, stream, a, dbg);
    run(5, 6); hipLaunchKernelGGL(chk_hact, dim3(256), dim3(256), 0, stream, a, dbg);
    run(6, 7); hipLaunchKernelGGL(chk_x2, dim3(256), dim3(256), 0, stream, a, dbg);
    run(7, 8); if (DEBUG_ONLY >= 0) hipLaunchKernelGGL(dbg_clear, dim3(MTOK * DM / 256), dim3(256), 0, stream, (float*)d_out); hipLaunchKernelGGL(dbg_apply, dim3(1), dim3(64), 0, stream, (const float*)dbg, (float*)d_out, DEBUG_ONLY, DEBUG_TOL);
#else
    run(0, 1); run(1, 2); attn(); run(3, 4); run(4, 5); run(5, 6); run(6, 7); run(7, 8);
#endif
}
```

```cpp
#include <hip/hip_runtime.h>
#include <hip/hip_cooperative_groups.h>
#include <cstdio>
#include <cstdint>
#include <cmath>
namespace cg = cooperative_groups;
__device__ __forceinline__ int lane_id_fresh() { int l; asm volatile("v_mbcnt_lo_u32_b32 %0, -1, 0\n\tv_mbcnt_hi_u32_b32 %0, -1, %0" : "=v"(l)); return l; }
#define TID_FRESH(wv) (((wv) << 6) | lane_id_fresh())
namespace pg8 {
#define PG8_LAS __attribute__((address_space(3)))
typedef unsigned short bf16_t;
typedef short bf16x8 __attribute__((ext_vector_type(8)));
typedef float f32x4 __attribute__((ext_vector_type(4)));
typedef unsigned u32x4 __attribute__((ext_vector_type(4)));
constexpr int BM = 256, BK = 64, HALF = 128, HTB = HALF * BK * 2  , STAGE_BYTES = 8 * HTB, NXCD = 8, WGM = 8;

__host__ __device__ __forceinline__ int lds_byte(int r, int c) { const int st = (r >> 4) * 2 + (c >> 5), rr = r & 15, cc = c & 31, ob = rr * 64 + cc * 2; return st * 1024 + (ob ^ (((ob >> 9) & 1) << 5)); }
__host__ __device__ __forceinline__ void stage_rc(int b, int& R, int& C) { const int st = b / 1024, sb = b % 1024, swz = sb ^ (((sb >> 9) & 1) << 5); R = (st >> 1) * 16 + swz / 64; C = (st & 1) * 32 + (swz % 64) / 2; }
__host__ __device__ __forceinline__ int perm32(int rho) { const int n = rho >> 4, i = rho & 15; return 8 * (i >> 2) + 4 * n + (i & 3); }

struct Unit { int pm, pn, kofs; };
struct Gemm { const bf16_t* A; const bf16_t* Bt; int lda, ldb, K; };

struct StaticOrder {
    int nM, nN, nwg, G, c;
    __host__ __device__ void init(int M, int N, int G_, int c_) { nM = M / BM; nN = N / BM; nwg = nM * nN; G = G_; c = c_; }
    __host__ __device__ bool tile(long L, Unit& u) const {
        if (L >= nwg) return false;
        int wgid = (int)L; { const int q = nwg / NXCD, r = nwg % NXCD, xcd = wgid % NXCD, off = wgid / NXCD; wgid = (xcd < r ? xcd * (q + 1) : r * (q + 1) + (xcd - r) * q) + off; }
        const int nig = WGM * nN, gid = wgid / nig, fm = gid * WGM, gsz = (nM - fm) < WGM ? (nM - fm) : WGM;
        u.pm = fm + ((wgid % nig) % gsz); u.pn = (wgid % nig) / gsz; u.kofs = 0; return true;
    }
    __host__ __device__ bool next(int i, Unit& u) const { return tile((long)i * G + c, u); }
};
struct HalfOrder : StaticOrder {
    int khalf;
    __host__ __device__ bool next(int i, Unit& u) const { if (!tile((long)(i >> 1) * G + c, u)) return false; u.kofs = (i & 1) * khalf; return true; }
};

typedef float f32x2_t __attribute__((ext_vector_type(2)));
typedef __bf16 bf16x2_t __attribute__((ext_vector_type(2)));
__device__ __forceinline__ unsigned cvt_pk_bf16(float lo, float hi) { f32x2_t v = {lo, hi}; bf16x2_t b = __builtin_convertvector(v, bf16x2_t); return __builtin_bit_cast(unsigned, b); }
__device__ __forceinline__ u32x4 pack8(f32x4 a, f32x4 b) { u32x4 w; w.x = cvt_pk_bf16(a[0], a[1]); w.y = cvt_pk_bf16(a[2], a[3]); w.z = cvt_pk_bf16(b[0], b[1]); w.w = cvt_pk_bf16(b[2], b[3]); return w; }
__device__ __forceinline__ float bf_lo(unsigned w) { return __builtin_bit_cast(float, w << 16); }
__device__ __forceinline__ float bf_hi(unsigned w) { return __builtin_bit_cast(float, w & 0xffff0000u); }

template <class Epi, class Sched, bool ALIGN_EPI>
__device__ __forceinline__ void gemm_phase(PG8_LAS unsigned char* lds, const Gemm g, const Sched& S, const Epi& E, const int wv) {
    const int tid = TID_FRESH(wv), wid = wv, lane = tid & 63, wr = wid >> 2, wc = wid & 3, fr = lane & 15, fq = lane >> 4;
    const int nt = g.K / BK;
    unsigned voffA[2], voffB[2];
#pragma unroll
    for (int i = 0; i < 2; ++i) { int R, C; stage_rc(tid * 16 + i * 8192, R, C); const int Rb = Epi::PERM ? ((R & ~31) + perm32(R & 31)) : R;
        voffA[i] = (unsigned)(R * g.lda + C) * 2u; voffB[i] = (unsigned)(Rb * g.ldb + C) * 2u; }
    const size_t kstep = (size_t)(BK * 2);
    const size_t hstepA = (size_t)HALF * g.lda * 2, hstepB = (size_t)HALF * g.ldb * 2;
    const size_t tstepA = 2 * hstepA, tstepB = 2 * hstepB;
    const unsigned ldsw = (unsigned)wid * 1024u;
    const int aoff = lds_byte(wr * 64 + fr, fq * 8), boff = lds_byte(wc * 32 + fr, fq * 8);
#define PG8_SA(b, h) (((b) * 2 + (h)) * HTB)
#define PG8_SB(b, h) ((4 + (b) * 2 + (h)) * HTB)
#define PG8_STAGE(bufoff, gbase, voff) do { _Pragma("unroll") for (int _i = 0; _i < 2; ++_i) \
        __builtin_amdgcn_global_load_lds((const unsigned*)((const char*)(gbase) + (voff)[_i]), (PG8_LAS unsigned*)(lds + (bufoff) + ldsw + _i * 8192), 16, 0, 0); } while (0)
#define PG8_LDA(dst, b, h) do { _Pragma("unroll") for (int m = 0; m < 4; ++m) _Pragma("unroll") for (int k = 0; k < 2; ++k) dst[m][k] = *(const PG8_LAS bf16x8*)(lds + PG8_SA(b, h) + aoff + m * 2048 + k * 1024); } while (0)
#define PG8_LDB(dst, b, h) do { _Pragma("unroll") for (int n = 0; n < 2; ++n) _Pragma("unroll") for (int k = 0; k < 2; ++k) dst[n][k] = *(const PG8_LAS bf16x8*)(lds + PG8_SB(b, h) + boff + n * 2048 + k * 1024); } while (0)
#define PG8_MMA(ai, bj, At, Bt) do { __builtin_amdgcn_s_setprio(1); _Pragma("unroll") for (int m = 0; m < 4; ++m) _Pragma("unroll") for (int n = 0; n < 2; ++n) _Pragma("unroll") for (int k = 0; k < 2; ++k) \
        acc[ai][bj][m][n] = __builtin_amdgcn_mfma_f32_16x16x32_bf16(Bt[n][k], At[m][k], acc[ai][bj][m][n], 0, 0, 0); __builtin_amdgcn_s_setprio(0); } while (0)
#define PG8_WAIT_V(n) asm volatile("s_waitcnt vmcnt(" #n ")" ::: "memory")
#define PG8_WAIT_L(n) asm volatile("s_waitcnt lgkmcnt(" #n ")" ::: "memory")
#define PG8_BAR __builtin_amdgcn_s_barrier()
#define PG8_SCHED __builtin_amdgcn_sched_barrier(0)
    Unit cur, nxt; int ui = 0;
    if (!S.next(0, cur)) return;
    f32x4 acc[2][2][4][2];
#pragma unroll
    for (int a = 0; a < 2; ++a)
#pragma unroll
        for (int b = 0; b < 2; ++b)
#pragma unroll
            for (int m = 0; m < 4; ++m)
#pragma unroll
                for (int n = 0; n < 2; ++n) acc[a][b][m][n] = (f32x4){0.f, 0.f, 0.f, 0.f};
    bf16x8 At[4][2], B0[2][2], B1[2][2];
    const char* cA = (const char*)g.A + (size_t)cur.pm * tstepA + (size_t)cur.kofs * 2; const char* cB = (const char*)g.Bt + (size_t)cur.pn * tstepB + (size_t)cur.kofs * 2;
    PG8_STAGE(PG8_SB(0, 0), cB, voffB); PG8_STAGE(PG8_SB(0, 1), cB + hstepB, voffB); PG8_STAGE(PG8_SA(0, 0), cA, voffA); PG8_STAGE(PG8_SA(0, 1), cA + hstepA, voffA);
    if (wr == 1) PG8_BAR;
    PG8_WAIT_V(2); PG8_BAR;
    PG8_STAGE(PG8_SB(1, 0), cB + kstep, voffB); PG8_STAGE(PG8_SA(1, 0), cA + kstep, voffA); PG8_STAGE(PG8_SB(1, 1), cB + hstepB + kstep, voffB);
    PG8_WAIT_V(6); PG8_BAR;
    for (;;) {
        const bool has_next = S.next(ui + 1, nxt);
        const char* nA = has_next ? (const char*)g.A + (size_t)nxt.pm * tstepA + (size_t)nxt.kofs * 2 : cA; const char* nB = has_next ? (const char*)g.Bt + (size_t)nxt.pn * tstepB + (size_t)nxt.kofs * 2 : cB;
        for (int t = 0; t < nt; t += 2) {
            const bool last = (t == nt - 2);
            const char* a1 = cA + (size_t)(t + 1) * kstep;
            const char* a2 = last ? nA : cA + (size_t)(t + 2) * kstep; const char* b2 = last ? nB : cB + (size_t)(t + 2) * kstep;
            const char* a3 = a2 + kstep; const char* b3 = b2 + kstep;
            PG8_LDB(B0, 0, 0); PG8_LDB(B1, 0, 1); PG8_SCHED; PG8_LDA(At, 0, 0); PG8_STAGE(PG8_SA(1, 1), a1 + hstepA, voffA);
            PG8_WAIT_V(8); PG8_WAIT_L(0); PG8_BAR; PG8_MMA(0, 0, At, B0); PG8_MMA(0, 1, At, B1); PG8_BAR; PG8_SCHED;
            PG8_LDA(At, 0, 1); PG8_STAGE(PG8_SB(0, 0), b2, voffB); PG8_STAGE(PG8_SB(0, 1), b2 + hstepB, voffB); PG8_STAGE(PG8_SA(0, 0), a2, voffA);
            PG8_WAIT_V(8); PG8_WAIT_L(0); PG8_BAR; PG8_MMA(1, 0, At, B0); PG8_MMA(1, 1, At, B1); PG8_BAR; PG8_SCHED;
            PG8_LDB(B0, 1, 0); PG8_LDB(B1, 1, 1); PG8_SCHED; PG8_LDA(At, 1, 0); PG8_STAGE(PG8_SA(0, 1), a2 + hstepA, voffA);
            PG8_WAIT_V(8); PG8_WAIT_L(0); PG8_BAR; PG8_MMA(0, 0, At, B0); PG8_MMA(0, 1, At, B1); PG8_BAR; PG8_SCHED;
            PG8_LDA(At, 1, 1); PG8_STAGE(PG8_SB(1, 0), b3, voffB); PG8_STAGE(PG8_SB(1, 1), b3 + hstepB, voffB); PG8_STAGE(PG8_SA(1, 0), a3, voffA);
            PG8_WAIT_V(8); PG8_WAIT_L(0); PG8_BAR; PG8_MMA(1, 0, At, B0); PG8_MMA(1, 1, At, B1); PG8_BAR; PG8_SCHED;
        }
        if constexpr (ALIGN_EPI) { if (wr == 0) PG8_BAR; }
        if constexpr (!Epi::AFTER_DRAIN) { Unit ce = cur; asm volatile("" : "+s"(ce.pm), "+s"(ce.pn), "+s"(ce.kofs));
            E(acc, ce, wr, wc, fr, fq); }
        if (!has_next) break;
#pragma unroll
        for (int a = 0; a < 2; ++a)
#pragma unroll
            for (int b = 0; b < 2; ++b)
#pragma unroll
                for (int m = 0; m < 4; ++m)
#pragma unroll
                    for (int n = 0; n < 2; ++n) acc[a][b][m][n] = (f32x4){0.f, 0.f, 0.f, 0.f};
        cur = nxt; cA = nA; cB = nB; ++ui;
        if constexpr (ALIGN_EPI) { if (wr == 1) PG8_BAR; }
    }
    PG8_WAIT_V(0);
    if constexpr (!ALIGN_EPI) { if (wr == 0) PG8_BAR; }
    PG8_BAR;
    if constexpr (Epi::AFTER_DRAIN) { E.fused(acc, cur, wr, wc, fr, fq, lds, wid, lane); }
#undef PG8_SA
#undef PG8_SB
#undef PG8_STAGE
#undef PG8_LDA
#undef PG8_LDB
#undef PG8_MMA
#undef PG8_WAIT_V
#undef PG8_WAIT_L
#undef PG8_BAR
#undef PG8_SCHED
}
}
constexpr int BATCH = 4, SEQ = 2048, DM = 2048, MTOK = BATCH * SEQ, NH = 8, HD = 128, DFF = 5632, INC = 10248, NIN = 10240, WID = 1024;
constexpr float RMS_EPS = 1e-6f;
constexpr int NWAVES = 8, NTHREADS = 512;

constexpr size_t MiB = 1u << 20;
constexpr size_t WS_CTL = 0;
constexpr size_t WS_LOGF = 1 * MiB, WS_CUM = WS_LOGF + 256 * 1024;
constexpr size_t WS_COS = 2 * MiB, WS_SIN = WS_COS + 512 * 1024;
constexpr size_t WS_KPART = 3 * MiB;
constexpr size_t WS_SSQ1 = 3 * MiB + 512 * 1024, WS_SSQ2 = WS_SSQ1 + 256 * 1024;
constexpr size_t WS_WIN = 8 * MiB, WS_WO = 48 * MiB, WS_WOUT = 56 * MiB, WS_WGU = 64 * MiB, WS_WD = 108 * MiB;
constexpr size_t WS_B = 130 * MiB;
constexpr size_t WS_D = 162 * MiB;
constexpr size_t WS_HACT = WS_B;
constexpr size_t WS_C = 226 * MiB;
constexpr size_t WS_X1 = WS_C, WS_X1B = WS_C + 64 * MiB;
constexpr size_t WS_END = 322 * MiB;
constexpr size_t QKV_ELEMS = (size_t)MTOK * WID;

typedef unsigned short bf16;
typedef float f32x4 __attribute__((ext_vector_type(4)));
typedef unsigned u32x4 __attribute__((ext_vector_type(4)));
#define LAS __attribute__((address_space(3)))

using pg8::Unit; using pg8::pack8; using pg8::bf_lo; using pg8::bf_hi;
__device__ __forceinline__ float fast_sigmoid(float x) { return __builtin_amdgcn_rcpf(1.f + __builtin_amdgcn_exp2f(-1.4426950408889634f * x)); }

struct EpiIn {
    static constexpr bool PERM = true, AFTER_DRAIN = false;
    bf16* qkv; bf16* gates; const float* cosT; const float* sinT; float* kpart;
    __device__ __forceinline__ void operator()(const f32x4 (&acc)[2][2][4][2], const Unit& u, int wr, int wc, int fr, int fq) const {
        const int row0 = u.pm * 256 + wr * 64 + fr;
        if (u.pn >= 24) {
            bf16* gb_ = gates + (u.pn >= 32 ? (size_t)MTOK * DM : 0);
            const int col0 = ((u.pn - 24) & 7) * 256 + wc * 32 + 8 * fq;
#pragma unroll
            for (int ai = 0; ai < 2; ++ai)
#pragma unroll
                for (int m = 0; m < 4; ++m) { bf16* rowp = gb_ + (size_t)(row0 + ai * 128 + m * 16) * DM + col0;
#pragma unroll
                    for (int bj = 0; bj < 2; ++bj) { f32x4 v0 = acc[ai][bj][m][0], v1 = acc[ai][bj][m][1];
#pragma unroll
                        for (int e = 0; e < 4; ++e) { v0[e] = fast_sigmoid(v0[e]); v1[e] = fast_sigmoid(v1[e]); }
                        *(u32x4*)(rowp + bj * 128) = pack8(v0, v1); }
                    asm volatile("" ::: "memory"); }
            return;
        }
        const int t = u.pn >> 2;
        bf16* base = qkv + (size_t)t * QKV_ELEMS;
        if (t != 3 && t != 4) {
            const int d0 = wc * 32 + 8 * fq;
#pragma unroll
            for (int ai = 0; ai < 2; ++ai)
#pragma unroll
                for (int m = 0; m < 4; ++m) { const int row = row0 + ai * 128 + m * 16, b = row >> 11, s = row & 2047;
#pragma unroll
                    for (int bj = 0; bj < 2; ++bj) { const int h = (u.pn & 3) * 2 + bj;
                        *(u32x4*)(base + ((size_t)((b * NH + h) * SEQ + s)) * HD + d0) = pack8(acc[ai][bj][m][0], acc[ai][bj][m][1]); }
                    asm volatile("" ::: "memory"); }
            return;
        }
        const int h = (u.pn & 3) * 2 + (wc >> 1), d1 = 32 * (wc & 1) + 8 * fq;
        f32x4 ks[2][2];
#pragma unroll
        for (int bj = 0; bj < 2; ++bj)
#pragma unroll
            for (int n = 0; n < 2; ++n) ks[bj][n] = (f32x4){0.f, 0.f, 0.f, 0.f};
#pragma unroll
        for (int ai = 0; ai < 2; ++ai)
#pragma unroll
            for (int m = 0; m < 4; ++m) { const int row = row0 + ai * 128 + m * 16, b = row >> 11, s = row & 2047;
                const f32x4 c0 = *(const f32x4*)(cosT + s * 64 + d1), c1 = *(const f32x4*)(cosT + s * 64 + d1 + 4);
                const f32x4 s0 = *(const f32x4*)(sinT + s * 64 + d1), s1 = *(const f32x4*)(sinT + s * 64 + d1 + 4);
                const f32x4 a0 = acc[ai][0][m][0], a1 = acc[ai][0][m][1], b0 = acc[ai][1][m][0], b1 = acc[ai][1][m][1];
                const f32x4 o10 = a0 * c0 - b0 * s0, o11 = a1 * c1 - b1 * s1, o20 = b0 * c0 + a0 * s0, o21 = b1 * c1 + a1 * s1;
                bf16* dst = base + ((size_t)((b * NH + h) * SEQ + s)) * HD + d1;
                *(u32x4*)(dst) = pack8(o10, o11); *(u32x4*)(dst + 64) = pack8(o20, o21);
                ks[0][0] += o10; ks[0][1] += o11; ks[1][0] += o20; ks[1][1] += o21;
                asm volatile("" : "+v"(ks[0][0]), "+v"(ks[0][1]), "+v"(ks[1][0]), "+v"(ks[1][1]) :: "memory"); }
        if (t == 4) {
#pragma unroll
            for (int bj = 0; bj < 2; ++bj)
#pragma unroll
                for (int n = 0; n < 2; ++n)
#pragma unroll
                    for (int e = 0; e < 4; ++e) { float v = ks[bj][n][e]; v += __shfl_xor(v, 1); v += __shfl_xor(v, 2); v += __shfl_xor(v, 4); v += __shfl_xor(v, 8); ks[bj][n][e] = v; }
            if (fr == 0) { float* kp = kpart + (size_t)(u.pm * 2 + wr) * 1024 + h * 128 + d1;
                *(f32x4*)(kp) = ks[0][0]; *(f32x4*)(kp + 4) = ks[0][1]; *(f32x4*)(kp + 64) = ks[1][0]; *(f32x4*)(kp + 68) = ks[1][1]; }
        }
    }
};

struct EpiY {
    static constexpr bool PERM = true, AFTER_DRAIN = false;
    const bf16* ga; const bf16* gb; float* T; bf16* y;
    __device__ __forceinline__ void operator()(const f32x4 (&acc)[2][2][4][2], const Unit& u, int wr, int wc, int fr, int fq) const {
        const int row0 = u.pm * 256 + wr * 64 + fr, col0 = u.pn * 256 + wc * 32 + 8 * fq;
        const bool first = (u.kofs == 0);
        const bf16* gsrc = first ? ga : gb;
#pragma unroll
        for (int ai = 0; ai < 2; ++ai)
#pragma unroll
            for (int m = 0; m < 4; ++m) {
#pragma unroll
                for (int bj = 0; bj < 2; ++bj) { const size_t off = (size_t)(row0 + ai * 128 + m * 16) * DM + col0 + bj * 128;
                    const u32x4 gw = *(const u32x4*)(gsrc + off);
                    f32x4 g0 = {bf_lo(gw.x), bf_hi(gw.x), bf_lo(gw.y), bf_hi(gw.y)}, g1 = {bf_lo(gw.z), bf_hi(gw.z), bf_lo(gw.w), bf_hi(gw.w)};
                    f32x4 v0 = acc[ai][bj][m][0] * g0, v1 = acc[ai][bj][m][1] * g1;
                    if (first) { *(f32x4*)(T + off) = v0; *(f32x4*)(T + off + 4) = v1; }
                    else { v0 += *(const f32x4*)(T + off); v1 += *(const f32x4*)(T + off + 4); *(u32x4*)(y + off) = pack8(v0, v1); } }
                asm volatile("" ::: "memory"); }
    }
};

struct EpiRes {
    static constexpr bool PERM = true, AFTER_DRAIN = true;
    const float* base; float* out; bf16* outb; float* ssq;
    __device__ __forceinline__ void fused(f32x4 (&acc)[2][2][4][2], const Unit& u, int wr, int wc, int fr, int fq, PG8_LAS unsigned char* lds, int wid, int lane) const {
        PG8_LAS float* P = (PG8_LAS float*)lds;
        const int row0 = u.pm * 256 + wr * 64 + fr, col0 = u.pn * 256 + wc * 32 + 8 * fq;
#pragma unroll
        for (int ai = 0; ai < 2; ++ai)
#pragma unroll
            for (int m = 0; m < 4; ++m) { float ss = 0.f;
#pragma unroll
                for (int bj = 0; bj < 2; ++bj) { const size_t off = (size_t)(row0 + ai * 128 + m * 16) * DM + col0 + bj * 128;
                    const f32x4 v0 = acc[ai][bj][m][0] + *(const f32x4*)(base + off), v1 = acc[ai][bj][m][1] + *(const f32x4*)(base + off + 4);
                    *(f32x4*)(out + off) = v0; *(f32x4*)(out + off + 4) = v1;
                    if (outb) *(u32x4*)(outb + off) = pack8(v0, v1);
                    ss += (v0[0] * v0[0] + v0[1] * v0[1]) + (v0[2] * v0[2] + v0[3] * v0[3]) + (v1[0] * v1[0] + v1[1] * v1[1]) + (v1[2] * v1[2] + v1[3] * v1[3]); }
                ss += __shfl_xor(ss, 16); ss += __shfl_xor(ss, 32);
                if (fq == 0) P[(ai * 128 + wr * 64 + m * 16 + fr) * 4 + wc] = ss;
                asm volatile("" ::: "memory"); }
        asm volatile("s_waitcnt lgkmcnt(0)" ::: "memory"); __builtin_amdgcn_s_barrier(); asm volatile("" ::: "memory");
        const int tid = wid * 64 + lane;
        if (tid < 256) { const float s = (P[tid * 4 + 0] + P[tid * 4 + 1]) + (P[tid * 4 + 2] + P[tid * 4 + 3]); ssq[(size_t)(u.pm * 256 + tid) * 8 + u.pn] = s; }
    }
};

struct EpiGU {
    static constexpr bool PERM = true, AFTER_DRAIN = false;
    const float* ssq; bf16* hact;
    __device__ __forceinline__ void operator()(const f32x4 (&acc)[2][2][4][2], const Unit& u, int wr, int wc, int fr, int fq) const {
        const int row0 = u.pm * 256 + wr * 64 + fr, col0 = u.pn * 128 + wc * 32 + 8 * fq;
#pragma unroll
        for (int ai = 0; ai < 2; ++ai)
#pragma unroll
            for (int m = 0; m < 4; ++m) { const int row = row0 + ai * 128 + m * 16;
                const f32x4 p0 = *(const f32x4*)(ssq + (size_t)row * 8), p1 = *(const f32x4*)(ssq + (size_t)row * 8 + 4);
                const float tot = ((p0[0] + p0[1]) + (p0[2] + p0[3])) + ((p1[0] + p1[1]) + (p1[2] + p1[3]));
                const float rstd = __builtin_amdgcn_rsqf(tot * (1.f / DM) + RMS_EPS);
                f32x4 o[2];
#pragma unroll
                for (int n = 0; n < 2; ++n)
#pragma unroll
                    for (int e = 0; e < 4; ++e) { const float g = acc[ai][0][m][n][e] * rstd, up = acc[ai][1][m][n][e] * rstd; o[n][e] = g * fast_sigmoid(g) * up; }
                *(u32x4*)(hact + (size_t)row * DFF + col0) = pack8(o[0], o[1]); }
    }
};
namespace att {
typedef short bf16x8 __attribute__((ext_vector_type(8)));
typedef short s16x4 __attribute__((ext_vector_type(4)));
typedef float f32x16 __attribute__((ext_vector_type(16)));
constexpr int NW = 8, QBLK = 32, KVBLK = 64, QB = NW * QBLK, D = 128, OP = 2048;
constexpr int SHM_V = KVBLK * D * 2, SHM_K = KVBLK * D * 2;
constexpr int LDS_WS = 2 * SHM_V + 2 * SHM_K;
constexpr int LDS_NCK = LDS_WS + NW * 64 * 4;
constexpr int LDS_KM = LDS_NCK + 2048 * 4;
constexpr int LDS_SCAN = LDS_KM + 8 * 128 * 4;
constexpr int LDS_END = LDS_SCAN + 64;
constexpr float LOG2E = 1.4426950408889634f, SCALE = 0.08838834764831845f, C2 = SCALE * LOG2E;
constexpr float THRL = 8.f * LOG2E;

#define KSWZ(row, colB) ((row) * 256 + ((colB) ^ (((row) & 7) << 4)))
#define SBAR() __builtin_amdgcn_sched_barrier(0)
__device__ __forceinline__ int v_st(int k, int c) { const int kk = (k & ~0xC) | ((k & 4) << 1) | ((k & 8) >> 1); return ((kk >> 3) * 4 + (c >> 5)) * 512 + ((kk & 7) * 32 + (c & 31)) * 2; }
__device__ __forceinline__ int v_rd_base(int lane) { return ((lane & 3) << 3) | (((lane >> 2) & 3) << 6) | (((lane >> 4) & 1) << 5) | (((lane >> 5) & 1) << 8); }
constexpr int v_rd_off(int d0, int ks, int half) { return d0 * 512 + ks * 4096 + half * 2048; }
__device__ __forceinline__ int crow(int r, int hi) { return (r & 3) + 8 * (r >> 2) + 4 * hi; }
__device__ __forceinline__ unsigned cvtpk(float lo, float hi) { return pg8::cvt_pk_bf16(lo, hi); }
__device__ __forceinline__ bf16x8 load8(const bf16* p) { return *reinterpret_cast<const bf16x8*>(p); }
__device__ __forceinline__ void mask_tile(f32x16& p0, f32x16& p1, int dq) {
    const float NEG = -__builtin_inff();
#pragma unroll
    for (int r = 0; r < 16; ++r) { const int c = (r & 3) + 8 * (r >> 2); if (dq - c < 0) p0[r] = NEG; if (dq - c - 32 < 0) p1[r] = NEG; }
}
template <int MODE>
__device__ __forceinline__ void partialSM(f32x16& p0, f32x16& p1, float& m_reg, float& mn, float& alpha, const LAS float* nck) {
    if (MODE == 0) {
#pragma unroll
        for (int g = 0; g < 4; ++g) { const f32x4 b0 = *(const LAS f32x4*)(nck + 8 * g), b1 = *(const LAS f32x4*)(nck + 32 + 8 * g);
#pragma unroll
            for (int e = 0; e < 4; ++e) { p0[4 * g + e] = fmaf(p0[4 * g + e], C2, b0[e]); p1[4 * g + e] = fmaf(p1[4 * g + e], C2, b1[e]); } }
    }
    float pmax = p0[0];
#pragma unroll
    for (int r = 1; r < 16; ++r) pmax = fmaxf(pmax, p0[r]);
#pragma unroll
    for (int r = 0; r < 16; ++r) pmax = fmaxf(pmax, p1[r]);
    { auto rr = __builtin_amdgcn_permlane32_swap(__float_as_uint(pmax), __float_as_uint(pmax), false, false);
      pmax = fmaxf(__uint_as_float(rr[0]), __uint_as_float(rr[1])); }
    if (MODE == 1) pmax *= C2;
    if (__builtin_expect(__all(pmax - m_reg <= THRL), 1)) { mn = m_reg; alpha = 1.f; }
    else { mn = fmaxf(m_reg, pmax); alpha = __builtin_amdgcn_exp2f(m_reg - mn); m_reg = mn; }
    if (MODE == 0) {
#pragma unroll
        for (int r = 0; r < 16; ++r) { p0[r] -= mn; p1[r] -= mn; }
    } else { const float mnL = -mn;
#pragma unroll
        for (int r = 0; r < 16; ++r) { p0[r] = fmaf(p0[r], C2, mnL); p1[r] = fmaf(p1[r], C2, mnL); }
    }
#pragma unroll
    for (int r = 0; r < 16; ++r) p0[r] = __builtin_amdgcn_exp2f(p0[r]);
}
__device__ __forceinline__ void finishSM(f32x16& p0, f32x16& p1, float alpha, float& l_reg, bf16x8& pa0, bf16x8& pa1, bf16x8& pa2, bf16x8& pa3) {
#pragma unroll
    for (int r = 0; r < 16; ++r) p1[r] = __builtin_amdgcn_exp2f(p1[r]);
    float ps = 0;
#pragma unroll
    for (int r = 0; r < 16; ++r) ps += p0[r];
#pragma unroll
    for (int r = 0; r < 16; ++r) ps += p1[r];
    { auto rr = __builtin_amdgcn_permlane32_swap(__float_as_uint(ps), __float_as_uint(ps), false, false);
      ps = __uint_as_float(rr[0]) + __uint_as_float(rr[1]); }
    l_reg = l_reg * alpha + ps;
#define PK4(P, B_, OUT) do { unsigned a0 = cvtpk(P[B_+0], P[B_+1]), a1 = cvtpk(P[B_+2], P[B_+3]);                          \
        unsigned b0 = cvtpk(P[B_+4], P[B_+5]), b1 = cvtpk(P[B_+6], P[B_+7]);                                             \
        auto r0 = __builtin_amdgcn_permlane32_swap(a0, b0, false, false); auto r1 = __builtin_amdgcn_permlane32_swap(a1, b1, false, false); \
        u32x4 w = {r0[0], r1[0], r0[1], r1[1]}; OUT = *reinterpret_cast<bf16x8*>(&w); } while (0)
    PK4(p0, 0, pa0); PK4(p0, 8, pa1); PK4(p1, 0, pa2); PK4(p1, 8, pa3);
#undef PK4
}
template <int KB>
__device__ __forceinline__ void qkt(f32x16& p0, f32x16& p1, const char* K_lds, int r32, int hi, const bf16x8* qr) {
    p0 = f32x16{}; p1 = f32x16{};
    const char* kb[4];
#pragma unroll
    for (int dd = 0; dd < 4; ++dd) kb[dd] = K_lds + KB * SHM_K + KSWZ(r32, (dd * 16 + hi * 8) * 2);
#pragma unroll
    for (int d0 = 0; d0 < 8; ++d0) { const char* a = kb[d0 & 3] + (d0 >> 2) * 128;
        bf16x8 b0 = *reinterpret_cast<const bf16x8*>(a);
        bf16x8 b1 = *reinterpret_cast<const bf16x8*>(a + 32 * 256);
        p0 = __builtin_amdgcn_mfma_f32_32x32x16_bf16(b0, qr[d0], p0, 0, 0, 0);
        p1 = __builtin_amdgcn_mfma_f32_32x32x16_bf16(b1, qr[d0], p1, 0, 0, 0); }
}
template <int VB>
__device__ __forceinline__ void pv_tile(f32x16* o, int vb0, bf16x8 pa0, bf16x8 pa1, bf16x8 pa2, bf16x8 pa3) {
#define TRRD(dst, off) asm volatile("ds_read_b64_tr_b16 %0, %1 offset:%2" : "=&v"(dst) : "v"(vb0), "i"(off) : "memory")
#define PV_D0(d0) do { s16x4 l0, l1, l2, l3, h0, h1, h2, h3; constexpr int b_ = VB * SHM_V + v_rd_off(d0, 0, 0);   \
        TRRD(l0, b_); TRRD(h0, b_ + 2048); TRRD(l1, b_ + 4096); TRRD(h1, b_ + 6144); TRRD(l2, b_ + 8192); TRRD(h2, b_ + 10240); TRRD(l3, b_ + 12288); TRRD(h3, b_ + 14336); \
        asm volatile("s_waitcnt lgkmcnt(0)" ::: "memory"); SBAR();             \
        o[d0] = __builtin_amdgcn_mfma_f32_32x32x16_bf16(pa0, (bf16x8){l0[0], l0[1], l0[2], l0[3], h0[0], h0[1], h0[2], h0[3]}, o[d0], 0, 0, 0);   \
        o[d0] = __builtin_amdgcn_mfma_f32_32x32x16_bf16(pa1, (bf16x8){l1[0], l1[1], l1[2], l1[3], h1[0], h1[1], h1[2], h1[3]}, o[d0], 0, 0, 0);   \
        o[d0] = __builtin_amdgcn_mfma_f32_32x32x16_bf16(pa2, (bf16x8){l2[0], l2[1], l2[2], l2[3], h2[0], h2[1], h2[2], h2[3]}, o[d0], 0, 0, 0);   \
        o[d0] = __builtin_amdgcn_mfma_f32_32x32x16_bf16(pa3, (bf16x8){l3[0], l3[1], l3[2], l3[3], h3[0], h3[1], h3[2], h3[3]}, o[d0], 0, 0, 0); } while (0)
    PV_D0(0); PV_D0(1); PV_D0(2); PV_D0(3);
#undef PV_D0
#undef TRRD
}

struct BlockRef { const bf16* Q; const bf16* K; const bf16* V; bf16* O; int P0; };
struct Seam { bf16x8 qr[8]; bf16x8 st_v0, st_v1, st_k0, st_k1; };
#define ROW(p, k0, rr) ((p) + (size_t)((k0) + (rr)) * D + sc)
#define VMW() asm volatile("s_waitcnt vmcnt(0)" ::: "memory")
#define VMWN(n) asm volatile("s_waitcnt vmcnt(%0)" :: "i"(n) : "memory")
#define SLOAD_H(Kp, Vp, k0) do { S.st_v0 = load8(ROW(Vp, k0, sr)); S.st_v1 = load8(ROW(Vp, k0, 32 + sr));              \
                         S.st_k0 = load8(ROW(Kp, k0, sr)); S.st_k1 = load8(ROW(Kp, k0, 32 + sr)); } while (0)
#define SWRITE_HK(bf) do { *(bf16x8*)(K_lds + (bf) * SHM_K + kws) = S.st_k0; *(bf16x8*)(K_lds + (bf) * SHM_K + kws + 32 * 256) = S.st_k1; } while (0)
#define SWRITE_HV(bf) do { *(bf16x8*)(V_lds + (bf) * SHM_V + vst0) = S.st_v0; *(bf16x8*)(V_lds + (bf) * SHM_V + vst1) = S.st_v1; } while (0)
#define SWRITE_H(bf) do { SWRITE_HV(bf); SWRITE_HK(bf); } while (0)
__device__ __forceinline__ void prime(const BlockRef& cur, char* lds, Seam& S, const int wv) {
    const int tid = TID_FRESH(wv), wid = wv, lane = tid & 63, r32 = lane & 31, hi = lane >> 5;
    const int sr = tid >> 4, sc = (tid & 15) * 8, kws = KSWZ(sr, sc * 2); char* K_lds = lds + 2 * SHM_V;
#pragma unroll
    for (int d0 = 0; d0 < 8; ++d0) S.qr[d0] = load8(cur.Q + (size_t)(wid * QBLK + r32) * D + d0 * 16 + hi * 8);
    SLOAD_H(cur.K, cur.V, 0); VMW(); SWRITE_HK(0);
    __syncthreads();
}
__device__ __forceinline__ unsigned moba_select(const Seam& S, int blk, LAS unsigned char* l3, int hi) {
    if (blk <= 3) return 0xffu;
    const LAS float* km = (const LAS float*)(l3 + LDS_KM) + hi * 8;
    float g[7];
#pragma unroll
    for (int n = 0; n < 7; ++n) g[n] = 0.f;
#pragma unroll
    for (int d0 = 0; d0 < 8; ++d0) { float qf[8];
#pragma unroll
        for (int j = 0; j < 4; ++j) { const unsigned w = ((const unsigned*)&S.qr[d0])[j]; qf[2 * j] = pg8::bf_lo(w); qf[2 * j + 1] = pg8::bf_hi(w); }
#pragma unroll
        for (int n = 0; n < 7; ++n) { const f32x4 k0 = *(const LAS f32x4*)(km + n * 128 + d0 * 16), k1 = *(const LAS f32x4*)(km + n * 128 + d0 * 16 + 4);
            g[n] += (qf[0] * k0[0] + qf[1] * k0[1]) + (qf[2] * k0[2] + qf[3] * k0[3]) + (qf[4] * k1[0] + qf[5] * k1[1]) + (qf[6] * k1[2] + qf[7] * k1[3]); }
        asm volatile("" : "+v"(g[0]), "+v"(g[1]), "+v"(g[2]), "+v"(g[3]), "+v"(g[4]), "+v"(g[5]), "+v"(g[6]) :: "memory"); }
#pragma unroll
    for (int n = 0; n < 7; ++n) g[n] += __shfl_xor(g[n], 32);
    unsigned selm = 0u;
#pragma unroll
    for (int n = 0; n < 7; ++n) { int rank = 0;
#pragma unroll
        for (int mm = 0; mm < 7; ++mm) if (mm != n) rank += (mm < blk && (g[mm] > g[n] || (g[mm] == g[n] && mm < n))) ? 1 : 0;
        if (n < blk && rank < 3) selm |= 1u << n; }
    return selm;
}
template <int MODE>
__device__ __forceinline__ void block(const BlockRef& cur, const BlockRef& nxt, char* lds, LAS unsigned char* l3, Seam& S, const unsigned selm_in, const int wv) {
    const int tid = TID_FRESH(wv), wid = wv, lane = tid & 63, r32 = lane & 31, hi = lane >> 5;
    const int NT = (cur.P0 + QB) / KVBLK;
    const int qlo = cur.P0 + wid * QBLK, qm = qlo + r32 - 4 * hi;
    char* V_lds = lds; char* K_lds = lds + 2 * SHM_V;
    float* ws = (float*)(lds + LDS_WS) + wid * 64; float* li_l = ws, * al_l = ws + 32;
    const LAS float* nck = (const LAS float*)(l3 + LDS_NCK) + 4 * hi;
    float m_reg = -1e30f, l_reg = 0; f32x16 o[4] = {};
    const int sr = tid >> 4, sc = (tid & 15) * 8, vst0 = v_st(sr, sc), vst1 = v_st(32 + sr, sc), kws = KSWZ(sr, sc * 2);
    const int vb0 = (int)(uintptr_t)V_lds + v_rd_base(lane);
    const bf16* Kh = cur.K; const bf16* Vh = cur.V;
    const unsigned selm = selm_in;
#define RESC(a) do { if (__any((a) < 1.f)) { if (hi == 0) al_l[r32] = (a); asm volatile("s_waitcnt lgkmcnt(0)" ::: "memory");              \
                     for (int d_ = 0; d_ < 4; ++d_) for (int r = 0; r < 16; ++r) o[d_][r] *= al_l[crow(r, hi)]; } } while (0)
#define KBASE(t) ((t) * KVBLK)
#define MASKT(P0_, P1_, t) do { const int kb_ = KBASE(t); if (kb_ + KVBLK - 1 > qlo) mask_tile(P0_, P1_, qm - kb_);                                     \
        if (MODE == 1 && kb_ < cur.P0) { const bool s_ = (selm >> (kb_ >> 8)) & 1u; if (!__all(s_)) { const float NEG_ = -__builtin_inff();              \
            _Pragma("unroll") for (int r = 0; r < 16; ++r) { P0_[r] = s_ ? P0_[r] : NEG_; P1_[r] = s_ ? P1_[r] : NEG_; } } } } while (0)
#define SEAM_K0() do { VMWN(8); SWRITE_HK(0); SBAR(); } while (0)
    f32x16 pA0, pA1, pB0, pB1; float mnA, mnB, alA, alB; bf16x8 pa0, pa1, pa2, pa3;
    SWRITE_HV(0); SBAR();
    if (NT > 1) SLOAD_H(Kh, Vh, KBASE(1));
    SBAR(); qkt<0>(pA0, pA1, K_lds, r32, hi, S.qr);
    MASKT(pA0, pA1, 0); partialSM<MODE>(pA0, pA1, m_reg, mnA, alA, nck + KBASE(0));
    if (NT > 1) { VMW(); SWRITE_H(1); }
    __syncthreads();
#define HALF_STEP(PX0, PX1, mnX, alX, PY0, PY1, alY, t, KB, VB, SB) do {                                                      \
        SBAR(); qkt<KB>(PX0, PX1, K_lds, r32, hi, S.qr);                                                                      \
        finishSM(PY0, PY1, alY, l_reg, pa0, pa1, pa2, pa3); SBAR();                                                           \
        if ((t) + 1 < NT) { SLOAD_H(Kh, Vh, KBASE((t) + 1)); SBAR(); }                                                        \
        pv_tile<VB>(o, vb0, pa0, pa1, pa2, pa3); MASKT(PX0, PX1, (t)); partialSM<MODE>(PX0, PX1, m_reg, mnX, alX, nck + KBASE(t)); \
        __syncthreads();                                                                                                      \
        if ((t) + 1 < NT) { VMW(); SWRITE_H(SB); }                                                                            \
        RESC(alX); __syncthreads(); } while (0)
    for (int t = 1; t + 1 < NT; t += 2) {
        HALF_STEP(pB0, pB1, mnB, alB, pA0, pA1, alA, t, 1, 0, 0);
        HALF_STEP(pA0, pA1, mnA, alA, pB0, pB1, alB, t + 1, 0, 1, 1);
    }
    const bool even = (NT & 1) == 0;
    if (even) { SBAR(); qkt<1>(pB0, pB1, K_lds, r32, hi, S.qr); SBAR(); }
    SLOAD_H(nxt.K, nxt.V, 0); SBAR();
#pragma unroll
    for (int d0 = 0; d0 < 8; ++d0) S.qr[d0] = load8(nxt.Q + (size_t)(wid * QBLK + r32) * D + d0 * 16 + hi * 8);
    SBAR();
    finishSM(pA0, pA1, alA, l_reg, pa0, pa1, pa2, pa3); SBAR();
    pv_tile<0>(o, vb0, pa0, pa1, pa2, pa3);
    if (even) { MASKT(pB0, pB1, NT - 1); partialSM<MODE>(pB0, pB1, m_reg, mnB, alB, nck + KBASE(NT - 1)); __syncthreads(); RESC(alB);
        finishSM(pB0, pB1, alB, l_reg, pa0, pa1, pa2, pa3); SBAR(); pv_tile<1>(o, vb0, pa0, pa1, pa2, pa3); }
    SBAR(); SEAM_K0();
    if (hi == 0) li_l[r32] = l_reg; asm volatile("s_waitcnt lgkmcnt(0)" ::: "memory");
    float rli[16];
#pragma unroll
    for (int r = 0; r < 16; ++r) rli[r] = __builtin_amdgcn_rcpf(li_l[crow(r, hi)]);
    bf16* Ow = cur.O + (size_t)(wid * QBLK) * OP;
#pragma unroll
    for (int r = 0; r < 16; ++r) { const int orow = crow(r, hi);
#pragma unroll
        for (int d0 = 0; d0 < 4; ++d0) { const float v = o[d0][r] * rli[r];
            const float vn = __shfl_xor(v, 1);
            if ((r32 & 1) == 0) *(unsigned*)(Ow + (size_t)orow * OP + d0 * 32 + r32) = cvtpk(v, vn); } }
    __syncthreads();
#undef RESC
#undef KBASE
#undef MASKT
#undef SEAM_K0
#undef HALF_STEP
}
#undef ROW
#undef VMW
#undef VMWN
#undef SLOAD_H
#undef SWRITE_HK
#undef SWRITE_HV
#undef SWRITE_H

template <int MODE>
__device__ __forceinline__ void item(unsigned char* wsb, int bh, int x, char* lds, LAS unsigned char* l3, const int wv) {
    const int tid = TID_FRESH(wv), lane = tid & 63, wid = wv;
    if (MODE == 0) {
        const f32x4 v = *(const f32x4*)((const float*)(wsb + WS_LOGF) + (size_t)bh * SEQ + 4 * tid);
        const float s1 = v[0], s2 = s1 + v[1], s3 = s2 + v[2], s4 = s3 + v[3];
        float inc = s4;
#pragma unroll
        for (int o = 1; o < 64; o <<= 1) { const float t = __shfl_up(inc, o); if (lane >= o) inc += t; }
        LAS float* tot = (LAS float*)(l3 + LDS_SCAN);
        if (lane == 63) tot[wid] = inc;
        __syncthreads();
        float base = inc - s4;
        for (int w = 0; w < wid; ++w) base += tot[w];
        *(LAS f32x4*)((LAS float*)(l3 + LDS_NCK) + 4 * tid) = (f32x4){-(base + s1) * LOG2E, -(base + s2) * LOG2E, -(base + s3) * LOG2E, -(base + s4) * LOG2E};
    } else {
        const int b = bh >> 3, h = bh & 7; const float* kp = (const float*)(wsb + WS_KPART);
        for (int i = tid; i < 8 * 128; i += NTHREADS) { const int n = i >> 7, d = i & 127; const float* p = kp + (size_t)((b * 8 + n) * 2) * 1024 + h * 128 + d;
            ((LAS float*)(l3 + LDS_KM))[i] = (p[0] + p[1024]) * (1.f / 256.f); }
    }
    __syncthreads();
    const bf16* qkv = (const bf16*)(wsb + WS_C) + (size_t)(MODE * 3) * QKV_ELEMS;
    bf16* ob = (bf16*)(wsb + WS_B) + MODE * WID + (bh & 7) * HD + (size_t)(bh >> 3) * SEQ * OP;
    BlockRef r0, r1;
    r0.Q = qkv + ((size_t)bh * SEQ + (size_t)x * QB) * D; r0.K = qkv + QKV_ELEMS + (size_t)bh * SEQ * D; r0.V = qkv + 2 * QKV_ELEMS + (size_t)bh * SEQ * D; r0.O = ob + (size_t)x * QB * OP; r0.P0 = x * QB;
    r1 = r0; r1.Q = qkv + ((size_t)bh * SEQ + (size_t)(7 - x) * QB) * D; r1.O = ob + (size_t)(7 - x) * QB * OP; r1.P0 = (7 - x) * QB;
    Seam S;
    prime(r0, lds, S, wv);
    for (int pass = 0; pass < 2; ++pass) { const BlockRef cur = pass ? r1 : r0; unsigned selm = 0xffu; if (MODE == 1) selm = moba_select(S, cur.P0 >> 8, l3, lane >> 5);
        asm volatile("" : "+v"(selm) :: "memory"); block<MODE>(cur, r1, lds, l3, S, selm, wv); }
}
#undef KSWZ
#undef SBAR
}
constexpr int LDS_BYTES = 147456;
struct Args { const float* in[11]; float* out; unsigned char* ws; int ph_lo, ph_hi; };

__device__ __forceinline__ float wave_sum(float v) {
#pragma unroll
    for (int o = 1; o < 64; o <<= 1) v += __shfl_xor(v, o);
    return v;
}
__device__ __forceinline__ unsigned f2bf(float f) { unsigned u = __builtin_bit_cast(unsigned, f); return (u + 0x7fffu + ((u >> 16) & 1u)) >> 16; }
__device__ __forceinline__ unsigned pk2(float lo, float hi) { return f2bf(lo) | (f2bf(hi) << 16); }

__device__ __forceinline__ void tr_item(const float* W, int ldw, int k0, int n0, bf16* WT, int ldt, int drow0, int dk0, const float* gk, LAS float* scr, int lane) {
#pragma unroll 8
    for (int i = 0; i < 32; ++i) { const int kk = 2 * i + (lane >> 5); float v = W[(size_t)(k0 + kk) * ldw + n0 + (lane & 31)]; if (gk) v *= gk[k0 + kk]; scr[kk * 33 + (lane & 31)] = v; }
    asm volatile("s_waitcnt lgkmcnt(0)" ::: "memory");
    const int c = lane & 7;
#pragma unroll
    for (int j = 0; j < 4; ++j) { const int n = (lane >> 3) + 8 * j; const LAS float* s = scr + (8 * c) * 33 + n;
        u32x4 o; o.x = pk2(s[0 * 33], s[1 * 33]); o.y = pk2(s[2 * 33], s[3 * 33]); o.z = pk2(s[4 * 33], s[5 * 33]); o.w = pk2(s[6 * 33], s[7 * 33]);
        *(u32x4*)(WT + (size_t)(drow0 + n) * ldt + dk0 + 8 * c) = o; }
    asm volatile("s_waitcnt lgkmcnt(0)" ::: "memory");
}

__device__ __forceinline__ void p0_prologue(const Args& a, LAS unsigned char* lds, int G, int vcu, const int wv) {
    const int tid = TID_FRESH(wv), lane = tid & 63, wave = wv;
    const float* x = a.in[0]; const float* nmix = a.in[1]; const float* w_in = a.in[2]; const float* bfg = a.in[3];
    unsigned char* ws = a.ws;
    LAS float* wfT = (LAS float*)lds;
    LAS float* scr = (LAS float*)(lds + 65536 + wave * 8448);
    for (int i = tid; i < 8 * 2048; i += NTHREADS) { const int k = i >> 3, jj = i & 7; wfT[jj * 2048 + k] = w_in[(size_t)k * INC + 6144 + jj]; }
    { float* cosT = (float*)(ws + WS_COS); float* sinT = (float*)(ws + WS_SIN);
      for (int i = vcu * NTHREADS + tid; i < SEQ * 64; i += G * NTHREADS) { const int pos = i >> 6, f = i & 63;
          const float inv = powf(10000.f, -(float)f / 64.f); const float ang = (float)pos * inv; float s, c; sincosf(ang, &s, &c); cosT[i] = c; sinT[i] = s; } }
    __syncthreads();
    const int gw = vcu * NWAVES + wave, NGW = G * NWAVES;
    { bf16* h1 = (bf16*)(ws + WS_B); float* logf = (float*)(ws + WS_LOGF);
      for (int m = gw; m < MTOK; m += NGW) {
          const f32x4* xr = (const f32x4*)(x + (size_t)m * DM) + lane; const f32x4* g4 = (const f32x4*)nmix + lane;
          f32x4 v[8]; float ss = 0.f;
#pragma unroll
          for (int j = 0; j < 8; ++j) { v[j] = xr[64 * j]; ss += (v[j][0] * v[j][0] + v[j][1] * v[j][1]) + (v[j][2] * v[j][2] + v[j][3] * v[j][3]); }
          ss = wave_sum(ss); const float rstd = 1.f / sqrtf(ss * (1.f / DM) + RMS_EPS);
          float fa[8];
#pragma unroll
          for (int jj = 0; jj < 8; ++jj) fa[jj] = 0.f;
          unsigned long long* o8 = (unsigned long long*)(h1 + (size_t)m * DM) + lane;
#pragma unroll
          for (int j = 0; j < 8; ++j) { const f32x4 hv = v[j] * g4[64 * j]; asm volatile("" ::: "memory");
#pragma unroll
              for (int jj = 0; jj < 8; ++jj) { const f32x4 w4 = *(const LAS f32x4*)(wfT + jj * 2048 + 256 * j + 4 * lane); fa[jj] += (hv[0] * w4[0] + hv[1] * w4[1]) + (hv[2] * w4[2] + hv[3] * w4[3]); }
              o8[64 * j] = (unsigned long long)pk2(hv[0] * rstd, hv[1] * rstd) | ((unsigned long long)pk2(hv[2] * rstd, hv[3] * rstd) << 32); }
#pragma unroll
          for (int jj = 0; jj < 8; ++jj) fa[jj] = wave_sum(fa[jj]) * rstd;
          float z = fa[0];
#pragma unroll
          for (int jj = 1; jj < 8; ++jj) z = (lane == jj) ? fa[jj] : z;
          if (lane < 8) { z += bfg[lane]; const float ls = -(fmaxf(-z, 0.f) + log1pf(expf(-fabsf(z)))); logf[(size_t)((m >> 11) * NH + lane) * SEQ + (m & 2047)] = ls; }
      } }
    constexpr int I_IN = 32 * 320, I_OF = 16 * 64, I_OM = 16 * 64, I_OUT = 32 * 64, I_GU = 32 * 352, I_D = 88 * 64;
    constexpr int NITEMS = I_IN + I_OF + I_OM + I_OUT + I_GU + I_D;
    for (int it = gw; it < NITEMS; it += NGW) {
        int r = it;
        if (r < I_IN) { const int kb = r / 320, ng = r % 320, dr = 32 * ng, pn = dr >> 8; int src;
            if (pn >= 12 && pn < 20) { const int slot = dr & 255, bj = slot >> 7, wc = (slot >> 5) & 3; src = (pn < 16 ? 3072 : 4096) + ((pn & 3) * 2 + (wc >> 1)) * 128 + 64 * bj + 32 * (wc & 1); }
            else src = dr < 6144 ? dr : dr + 8;
            tr_item(w_in, INC, 64 * kb, src, (bf16*)(ws + WS_WIN), DM, dr, 64 * kb, nullptr, scr, lane); continue; } r -= I_IN;
        if (r < I_OF) { const int kb = r / 64, ng = r % 64; tr_item(a.in[4], DM, 64 * kb, 32 * ng, (bf16*)(ws + WS_WO), 2048, 32 * ng, 64 * kb, nullptr, scr, lane); continue; } r -= I_OF;
        if (r < I_OM) { const int kb = r / 64, ng = r % 64; tr_item(a.in[5], DM, 64 * kb, 32 * ng, (bf16*)(ws + WS_WO), 2048, 32 * ng, 1024 + 64 * kb, nullptr, scr, lane); continue; } r -= I_OM;
        if (r < I_OUT) { const int kb = r / 64, ng = r % 64; tr_item(a.in[6], DM, 64 * kb, 32 * ng, (bf16*)(ws + WS_WOUT), DM, 32 * ng, 64 * kb, nullptr, scr, lane); continue; } r -= I_OUT;
        if (r < I_GU) { const int kb = r / 352, ng = r % 352, dr = 32 * ng, pn = dr >> 8, slot = dr & 255, bj = slot >> 7, s = slot & 127;
            tr_item(a.in[8], 2 * DFF, 64 * kb, bj * DFF + pn * 128 + s, (bf16*)(ws + WS_WGU), DM, dr, 64 * kb, a.in[7], scr, lane); continue; } r -= I_GU;
        { const int kb = r / 64, ng = r % 64; tr_item(a.in[9], DM, 64 * kb, 32 * ng, (bf16*)(ws + WS_WD), DFF, 32 * ng, 64 * kb, nullptr, scr, lane); }
    }
}

__device__ __forceinline__ void final_norm(const Args& a, int G, int vcu, const int wv) {
    const int tid = TID_FRESH(wv), lane = tid & 63, wave = wv;
    const int gw = vcu * NWAVES + wave, NGW = G * NWAVES;
    const f32x4* g4 = (const f32x4*)a.in[10] + lane;
    for (int m = gw; m < MTOK; m += NGW) {
        f32x4* xr = (f32x4*)(a.out + (size_t)m * DM) + lane;
        f32x4 v[8]; float ss = 0.f;
#pragma unroll
        for (int j = 0; j < 8; ++j) { v[j] = xr[64 * j]; ss += (v[j][0] * v[j][0] + v[j][1] * v[j][1]) + (v[j][2] * v[j][2] + v[j][3] * v[j][3]); }
        ss = wave_sum(ss); const float rstd = 1.f / sqrtf(ss * (1.f / DM) + RMS_EPS);
#pragma unroll
        for (int j = 0; j < 8; ++j) xr[64 * j] = v[j] * rstd * g4[64 * j];
    }
}

__global__ void scan_naive(const float* logf, float* cum) {
    const int i = blockIdx.x * blockDim.x + threadIdx.x; if (i >= BATCH * NH) return;
    float c = 0.f; for (int s = 0; s < SEQ; ++s) { c += logf[(size_t)i * SEQ + s]; cum[(size_t)i * SEQ + s] = c; }
}
__device__ __forceinline__ float wave_max(float v) {
#pragma unroll
    for (int o = 1; o < 64; o <<= 1) v = fmaxf(v, __shfl_xor(v, o));
    return v;
}
template <int MODE>
__global__ void __launch_bounds__(256) attn_naive(const bf16* Q, const bf16* K, const bf16* V, const float* cum, const float* kpart, bf16* O) {
    __shared__ float sc[4][2048]; __shared__ float qs[4][128];
    const int lane = threadIdx.x & 63, w = threadIdx.x >> 6;
    const int idx = blockIdx.x * 4 + w, bh = idx >> 11, t = idx & 2047, b = bh >> 3, h = bh & 7;
    const bf16* q = Q + ((size_t)bh * SEQ + t) * HD; const bf16* kb = K + (size_t)bh * SEQ * HD; const bf16* vb = V + (size_t)bh * SEQ * HD;
    { const unsigned qw = *(const unsigned*)(q + 2 * lane); qs[w][2 * lane] = pg8::bf_lo(qw); qs[w][2 * lane + 1] = pg8::bf_hi(qw); }
    __syncthreads();
    const float scale = 0.08838834764831845f;
    const int blk = t >> 8;
    unsigned sel = (1u << blk) - 1u;
    if (MODE == 1 && blk > 3) {
        float g = -__builtin_inff();
        if (lane < blk) { const float* k0 = kpart + (size_t)((b * 8 + lane) * 2) * 1024 + h * 128; float acc = 0.f;
            for (int d = 0; d < 128; ++d) acc += qs[w][d] * ((k0[d] + k0[1024 + d]) * (1.f / 256.f)); g = acc; }
        int rank = 0;
        for (int mm = 0; mm < 8; ++mm) { const float gm = __shfl(g, mm); if (mm < blk && (gm > g || (gm == g && mm < lane))) ++rank; }
        const unsigned long long bal = __ballot(lane < blk && rank < 3);
        sel = (unsigned)bal;
    }
    const float ct = (MODE == 0) ? cum[(size_t)bh * SEQ + t] : 0.f;
    float mx = -__builtin_inff();
    for (int k0 = 0; k0 <= t; k0 += 64) {
        const int kblk = k0 >> 8;
        if (MODE == 1 && kblk != blk && !((sel >> kblk) & 1u)) { sc[w][k0 + lane] = -__builtin_inff(); continue; }
        const int key = k0 + lane; float s = -__builtin_inff();
        if (key <= t) { const u32x4* kr = (const u32x4*)(kb + (size_t)key * HD); float acc = 0.f;
#pragma unroll 4
            for (int c = 0; c < 16; ++c) { const u32x4 kw = kr[c]; const float* qq = &qs[w][8 * c];
                acc += qq[0] * pg8::bf_lo(kw.x) + qq[1] * pg8::bf_hi(kw.x) + qq[2] * pg8::bf_lo(kw.y) + qq[3] * pg8::bf_hi(kw.y) + qq[4] * pg8::bf_lo(kw.z) + qq[5] * pg8::bf_hi(kw.z) + qq[6] * pg8::bf_lo(kw.w) + qq[7] * pg8::bf_hi(kw.w); }
            s = acc * scale; if (MODE == 0) s += ct - cum[(size_t)bh * SEQ + key]; }
        sc[w][key] = s; mx = fmaxf(mx, s);
    }
    mx = wave_max(mx);
    float sum = 0.f;
    const int kend = (t | 63) + 1;
    for (int key = lane; key < kend; key += 64) { const float s = sc[w][key]; const float p = (s == -__builtin_inff()) ? 0.f : __expf(s - mx); sc[w][key] = p; sum += p; }
    sum = wave_sum(sum);
    __syncthreads();
    float o0 = 0.f, o1 = 0.f;
    for (int k0 = 0; k0 <= t; k0 += 64) {
        const int kblk = k0 >> 8;
        if (MODE == 1 && kblk != blk && !((sel >> kblk) & 1u)) continue;
        const int ke = (k0 + 64 <= t + 1) ? 64 : (t + 1 - k0);
        for (int j = 0; j < ke; ++j) { const float p = sc[w][k0 + j]; const unsigned vw = *(const unsigned*)(vb + (size_t)(k0 + j) * HD + 2 * lane); o0 += p * pg8::bf_lo(vw); o1 += p * pg8::bf_hi(vw); }
    }
    const float inv = 1.f / sum;
    *(unsigned*)(O + (size_t)(b * SEQ + t) * DM + h * HD + 2 * lane) = pk2(o0 * inv, o1 * inv);
}

__global__ void __launch_bounds__(NTHREADS, 2) mega(Args a) {
    extern __shared__ __attribute__((aligned(16))) unsigned char lds_raw[];
    LAS unsigned char* lds = (LAS unsigned char*)lds_raw;
    cg::grid_group grid = cg::this_grid();
    const int wv = __builtin_amdgcn_readfirstlane(threadIdx.x >> 6);
    const int G = gridDim.x, bx = blockIdx.x, vcu = (G % 8 == 0) ? (bx % 8) * (G / 8) + bx / 8 : bx;
    unsigned char* ws = a.ws;
    const int lo = a.ph_lo, hi = a.ph_hi;
#define IN(k) (lo <= (k) && (k) < hi)
#define SEAM(k) do { if (IN(k) && IN((k) + 1)) grid.sync(); } while (0)
    if (IN(0)) { p0_prologue(a, lds, G, vcu, wv); }
    SEAM(0);
    if (IN(1)) {
        pg8::Gemm g{(const bf16*)(ws + WS_B), (const bf16*)(ws + WS_WIN), DM, DM, DM}; pg8::StaticOrder S; S.init(MTOK, NIN, G, bx);
        EpiIn E{(bf16*)(ws + WS_C), (bf16*)(ws + WS_D), (const float*)(ws + WS_COS), (const float*)(ws + WS_SIN), (float*)(ws + WS_KPART)};
        pg8::gemm_phase<EpiIn, pg8::StaticOrder, true>(lds, g, S, E, wv);
    }
    SEAM(1);
    if (IN(2)) {
        for (int it = bx; it < 2 * BATCH * NH * 4; it += G) { const int slot = it >> 3, g = (it & 7) * 8 + (slot >> 2), x = slot & 3, bh = g >> 1;
            if ((g & 1) == 0) att::item<0>(ws, bh, x, (char*)lds_raw, lds, wv); else att::item<1>(ws, bh, x, (char*)lds_raw, lds, wv); }
    }
    SEAM(2);
    if (IN(3)) {
        pg8::Gemm g{(const bf16*)(ws + WS_B), (const bf16*)(ws + WS_WO), DM, DM, WID}; pg8::HalfOrder S; S.init(MTOK, DM, G, bx); S.khalf = WID;
        EpiY E{(const bf16*)(ws + WS_D), (const bf16*)(ws + WS_D + 32 * MiB), (float*)(ws + WS_X1), (bf16*)(ws + WS_D)};
        pg8::gemm_phase<EpiY, pg8::HalfOrder, true>(lds, g, S, E, wv);
    }
    SEAM(3);
    if (IN(4)) {
        pg8::Gemm g{(const bf16*)(ws + WS_D), (const bf16*)(ws + WS_WOUT), DM, DM, DM}; pg8::StaticOrder S; S.init(MTOK, DM, G, bx);
        EpiRes E{a.in[0], (float*)(ws + WS_X1), (bf16*)(ws + WS_X1B), (float*)(ws + WS_SSQ1)};
        pg8::gemm_phase<EpiRes, pg8::StaticOrder, false>(lds, g, S, E, wv);
    }
    SEAM(4);
    if (IN(5)) {
        pg8::Gemm g{(const bf16*)(ws + WS_X1B), (const bf16*)(ws + WS_WGU), DM, DM, DM}; pg8::StaticOrder S; S.init(MTOK, 2 * DFF, G, bx);
        EpiGU E{(const float*)(ws + WS_SSQ1), (bf16*)(ws + WS_HACT)};
        pg8::gemm_phase<EpiGU, pg8::StaticOrder, true>(lds, g, S, E, wv);
    }
    SEAM(5);
    if (IN(6)) {
        pg8::Gemm g{(const bf16*)(ws + WS_HACT), (const bf16*)(ws + WS_WD), DFF, DFF, DFF}; pg8::StaticOrder S; S.init(MTOK, DM, G, bx);
        EpiRes E{(const float*)(ws + WS_X1), a.out, nullptr, (float*)(ws + WS_SSQ2)};
        pg8::gemm_phase<EpiRes, pg8::StaticOrder, false>(lds, g, S, E, wv);
    }
    SEAM(6);
    if (IN(7)) { final_norm(a, G, vcu, wv); }
#undef IN
#undef SEAM
}

#ifdef DEBUG_CHECKS
constexpr size_t WS_DBG = 4 * MiB;
__device__ __forceinline__ float bf2f(bf16 v) { return __builtin_bit_cast(float, (unsigned)v << 16); }
__device__ __forceinline__ void dbg_record(float* dbg, int k, float got, float ref, float floor_) {
    float e = fabsf(got - ref) / (fabsf(ref) + floor_); if (!(e == e)) e = 1e9f;
    atomicMax((int*)(dbg + k), __float_as_int(e));
}
__device__ __forceinline__ float block_sum256(float v, float* red) {
    v = wave_sum(v); __syncthreads(); if ((threadIdx.x & 63) == 0) red[threadIdx.x >> 6] = v; __syncthreads();
    return red[0] + red[1] + red[2] + red[3];
}
__device__ __forceinline__ unsigned hash_u(unsigned x) { x ^= x >> 16; x *= 0x7feb352du; x ^= x >> 15; x *= 0x846ca68bu; x ^= x >> 16; return x; }

__global__ void chk_p0(Args a, float* dbg) {
    __shared__ float red[4];
    const int m = hash_u(blockIdx.x * 7919u + 13u) % MTOK; const float* x = a.in[0] + (size_t)m * DM;
    float ss = 0.f; for (int k = threadIdx.x; k < DM; k += 256) ss += x[k] * x[k];
    ss = block_sum256(ss, red); const float rstd = 1.f / sqrtf(ss / DM + RMS_EPS);
    const bf16* h1 = (const bf16*)(a.ws + WS_B) + (size_t)m * DM;
    for (int k = threadIdx.x; k < DM; k += 256) dbg_record(dbg, 0, bf2f(h1[k]), x[k] * rstd * a.in[1][k], 0.02f);
    for (int h = 0; h < 8; ++h) { float acc = 0.f; for (int k = threadIdx.x; k < DM; k += 256) acc += x[k] * rstd * a.in[1][k] * a.in[2][(size_t)k * INC + 6144 + h];
        acc = block_sum256(acc, red); const float z = acc + a.in[3][h]; const float ref = z < 0.f ? z - log1pf(expf(z)) : -log1pf(expf(-z));
        if (threadIdx.x == 0) dbg_record(dbg, 1, ((const float*)(a.ws + WS_LOGF))[(size_t)((m >> 11) * NH + h) * SEQ + (m & 2047)], ref, 0.01f); }
}
__global__ void chk_in(Args a, float* dbg) {
    __shared__ float red[4];
    const unsigned hs = hash_u(blockIdx.x * 2654435761u + 99u);
    const int grp = blockIdx.x % 8, m = hs % MTOK, b = m >> 11, s = m & 2047;
    const bf16* h1 = (const bf16*)(a.ws + WS_B) + (size_t)m * DM; const float* w = a.in[2];
    const bf16* qkv = (const bf16*)(a.ws + WS_C);
    if (grp < 6) {
        const int h = (hs >> 13) % 8, d = (hs >> 17) % 64;
        const int c1 = grp * 1024 + h * 128 + d, c2 = c1 + 64;
        float a1 = 0.f, a2 = 0.f; for (int k = threadIdx.x; k < DM; k += 256) { const float hv = bf2f(h1[k]); a1 += hv * w[(size_t)k * INC + c1]; a2 += hv * w[(size_t)k * INC + c2]; }
        a1 = block_sum256(a1, red); a2 = block_sum256(a2, red);
        float r1 = a1, r2 = a2;
        if (grp == 3 || grp == 4) { const float inv = powf(10000.f, -(float)d / 64.f), ang = (float)s * inv; const float cs = cosf(ang), sn = sinf(ang); r1 = a1 * cs - a2 * sn; r2 = a2 * cs + a1 * sn; }
        if (threadIdx.x == 0) { const bf16* p = qkv + (size_t)grp * QKV_ELEMS + ((size_t)((b * NH + h) * SEQ + s)) * HD;
            dbg_record(dbg, 2 + grp, bf2f(p[d]), r1, 0.5f); dbg_record(dbg, 2 + grp, bf2f(p[d + 64]), r2, 0.5f);
            const bool rot = (grp == 3 || grp == 4);
            if (((m >> 7) & 1) && (rot ? h >= 6 : h == 7)) dbg_record(dbg, 40 + grp, bf2f(p[d + 64]), r2, 0.05f); }
    } else {
        const int n = (hs >> 13) % 2048, c = (grp == 6 ? 6152 : 8200) + n;
        float a1 = 0.f; for (int k = threadIdx.x; k < DM; k += 256) a1 += bf2f(h1[k]) * w[(size_t)k * INC + c];
        a1 = block_sum256(a1, red);
        float am = 0.f, ap = 0.f; for (int k = threadIdx.x; k < DM; k += 256) { am += bf2f(h1[k]) * w[(size_t)k * INC + c - 8]; ap += bf2f(h1[k]) * w[(size_t)k * INC + (c + 8 < INC ? c + 8 : c)]; }
        am = block_sum256(am, red); ap = block_sum256(ap, red);
        if (threadIdx.x == 0) { const bf16* g = (const bf16*)(a.ws + WS_D) + (grp == 7 ? (size_t)MTOK * DM : 0) + (size_t)m * DM + n; const float got = bf2f(*g); dbg_record(dbg, 2 + grp, got, 1.f / (1.f + expf(-a1)), 0.1f);
            if (grp == 6) { dbg_record(dbg, 21, got, 1.f / (1.f + expf(-am)), 0.02f); dbg_record(dbg, 22, got, 1.f / (1.f + expf(-ap)), 0.02f); dbg_record(dbg, 23, got, 1.f / (1.f + expf(a1)), 0.02f); dbg_record(dbg, 24, got, a1, 0.02f);
                const float g2 = bf2f(g[(size_t)MTOK * DM]); dbg_record(dbg, 25, g2, 1.f / (1.f + expf(-a1)), 0.02f);
                const int tile_par = (n >> 8) & 1; dbg_record(dbg, 26 + tile_par, got, 1.f / (1.f + expf(-a1)), 0.02f);
                dbg_record(dbg, 28 + ((n >> 7) & 1), got, 1.f / (1.f + expf(-a1)), 0.02f);
                dbg_record(dbg, 30 + ((m >> 7) & 1), got, 1.f / (1.f + expf(-a1)), 0.02f);
                if (((n >> 8) & 1) && ((n >> 7) & 1) && ((m >> 7) & 1)) { dbg_record(dbg, 32 + (n >> 9), got, 1.f / (1.f + expf(-a1)), 0.02f);
                    dbg_record(dbg, 36 + (((m >> 8) & 7) >> 2), got, 1.f / (1.f + expf(-a1)), 0.02f); } } }
    }
}
__global__ void chk_kpart(Args a, float* dbg) {
    const unsigned hs = hash_u(blockIdx.x * 40503u + 7u); const int pm = hs % 32, h = (hs >> 8) % 8, d = threadIdx.x & 127, b = pm >> 3, blk = pm & 7;
    if (threadIdx.x >= 128) return;
    const bf16* kb = (const bf16*)(a.ws + WS_C) + 4 * QKV_ELEMS + ((size_t)((b * NH + h) * SEQ + blk * 256)) * HD;
    float acc = 0.f; for (int r = 0; r < 256; ++r) acc += bf2f(kb[(size_t)r * HD + d]);
    const float* kp = (const float*)(a.ws + WS_KPART) + (size_t)(pm * 2) * 1024 + h * 128 + d;
    dbg_record(dbg, 10, kp[0] + kp[1024], acc, 4.0f);
}
__global__ void chk_attn(Args a, float* dbg, float* scratch  ) {
    const int id = blockIdx.x * blockDim.x + threadIdx.x; const int mode = id & 1;
    const unsigned hs = hash_u(id * 97u + 5u); const int b = hs % 4, h = (hs >> 4) % 8; int t = (hs >> 8) % 2048; if ((id >> 1) % 4 == 0) t = 1024 + (t % 1024);
    const bf16* base = (const bf16*)(a.ws + WS_C) + (size_t)(mode * 3) * QKV_ELEMS;
    const bf16* q = base + ((size_t)((b * NH + h) * SEQ + t)) * HD; const bf16* K = base + QKV_ELEMS + (size_t)(b * NH + h) * SEQ * HD; const bf16* V = base + 2 * QKV_ELEMS + (size_t)(b * NH + h) * SEQ * HD;
    float* lg = scratch + (size_t)id * 2048;
    const int blk = t >> 8; unsigned selm = (1u << blk) - 1u;
    if (mode == 1 && blk > 3) { float g[8];
#pragma unroll
        for (int n = 0; n < 8; ++n) { float acc = 0.f; const float* kp = (const float*)(a.ws + WS_KPART) + (size_t)((b * 8 + n) * 2) * 1024 + h * 128;
            if (n < blk) for (int d = 0; d < 128; ++d) acc += bf2f(q[d]) * ((kp[d] + kp[1024 + d]) / 256.f); g[n] = acc; }
        selm = 0u;
#pragma unroll
        for (int n = 0; n < 8; ++n) { int rank = 0;
#pragma unroll
            for (int mm = 0; mm < 8; ++mm) if (mm < blk && (g[mm] > g[n] || (g[mm] == g[n] && mm < n))) ++rank;
            if (n < blk && rank < 3) selm |= 1u << n; } }
    const float* logf = (const float*)(a.ws + WS_LOGF) + (size_t)(b * NH + h) * SEQ;
    float ct = 0.f; if (mode == 0) for (int s = 0; s <= t; ++s) ct += logf[s];
    float cs = 0.f, mx = -1e30f;
    for (int s = 0; s <= t; ++s) { if (mode == 0) cs += logf[s];
        bool ok = (mode == 0) || (s >> 8) == blk || ((selm >> (s >> 8)) & 1u);
        float acc = 0.f; if (ok) for (int d = 0; d < 128; ++d) acc += bf2f(q[d]) * bf2f(K[(size_t)s * HD + d]);
        float l = ok ? acc * 0.08838834764831845f + (mode == 0 ? ct - cs : 0.f) : -1e30f; lg[s] = l; mx = fmaxf(mx, l); }
    float sum = 0.f; for (int s = 0; s <= t; ++s) { const float p = lg[s] < -1e29f ? 0.f : expf(lg[s] - mx); lg[s] = p; sum += p; }
    const bf16* O = (const bf16*)(a.ws + WS_B) + (size_t)(b * SEQ + t) * DM + mode * WID + h * HD;
    for (int d = 0; d < 128; d += 9) { float acc = 0.f; for (int s = 0; s <= t; ++s) acc += lg[s] * bf2f(V[(size_t)s * HD + d]); dbg_record(dbg, 11 + mode, bf2f(O[d]), acc / sum, 0.02f); }
}
__global__ void chk_y(Args a, float* dbg, float* yref, int phase) {
    __shared__ float red[4];
    const unsigned hs = hash_u(blockIdx.x * 31337u + 3u); const int m = hs % MTOK, n = (hs >> 13) % DM;
    if (phase == 0) { const bf16* o = (const bf16*)(a.ws + WS_B) + (size_t)m * DM; float a1 = 0.f, a2 = 0.f;
        for (int k = threadIdx.x; k < WID; k += 256) { a1 += bf2f(o[k]) * a.in[4][(size_t)k * DM + n]; a2 += bf2f(o[WID + k]) * a.in[5][(size_t)k * DM + n]; }
        a1 = block_sum256(a1, red); a2 = block_sum256(a2, red);
        if (threadIdx.x == 0) { const bf16* ga = (const bf16*)(a.ws + WS_D) + (size_t)m * DM + n; yref[blockIdx.x] = bf2f(ga[0]) * a1 + bf2f(ga[(size_t)MTOK * DM]) * a2; } }
    else if (threadIdx.x == 0) dbg_record(dbg, 13, bf2f(((const bf16*)(a.ws + WS_D))[(size_t)m * DM + n]), yref[blockIdx.x], 0.02f);
}
__global__ void chk_x1(Args a, float* dbg) {
    __shared__ float red[4];
    const unsigned hs = hash_u(blockIdx.x * 1299709u + 17u); const int m = hs % MTOK, n = (hs >> 13) % DM;
    const bf16* y = (const bf16*)(a.ws + WS_D) + (size_t)m * DM; float a1 = 0.f;
    for (int k = threadIdx.x; k < DM; k += 256) a1 += bf2f(y[k]) * a.in[6][(size_t)k * DM + n];
    a1 = block_sum256(a1, red);
    const float* x1 = (const float*)(a.ws + WS_X1) + (size_t)m * DM;
    float ss = 0.f; for (int k = threadIdx.x; k < DM; k += 256) ss += x1[k] * x1[k]; ss = block_sum256(ss, red);
    if (threadIdx.x == 0) { dbg_record(dbg, 14, x1[n], a.in[0][(size_t)m * DM + n] + a1, 0.05f); dbg_record(dbg, 15, bf2f(((const bf16*)(a.ws + WS_X1B))[(size_t)m * DM + n]), x1[n], 0.05f);
        const float* sq = (const float*)(a.ws + WS_SSQ1) + (size_t)m * 8; float tot = 0.f; for (int i = 0; i < 8; ++i) tot += sq[i]; dbg_record(dbg, 16, tot, ss, 1.f); }
}
__global__ void chk_hact(Args a, float* dbg) {
    __shared__ float red[4];
    const unsigned hs = hash_u(blockIdx.x * 15485863u + 29u); const int m = hs % MTOK, j = (hs >> 13) % DFF;
    const float* x1 = (const float*)(a.ws + WS_X1) + (size_t)m * DM;
    float ss = 0.f; for (int k = threadIdx.x; k < DM; k += 256) ss += x1[k] * x1[k]; ss = block_sum256(ss, red); const float rstd = 1.f / sqrtf(ss / DM + RMS_EPS);
    float g = 0.f, u = 0.f; for (int k = threadIdx.x; k < DM; k += 256) { const float hv = x1[k] * rstd * a.in[7][k]; g += hv * a.in[8][(size_t)k * 2 * DFF + j]; u += hv * a.in[8][(size_t)k * 2 * DFF + DFF + j]; }
    g = block_sum256(g, red); u = block_sum256(u, red);
    if (threadIdx.x == 0) dbg_record(dbg, 17, bf2f(((const bf16*)(a.ws + WS_HACT))[(size_t)m * DFF + j]), g / (1.f + expf(-g)) * u, 0.02f);
}
__global__ void chk_x2(Args a, float* dbg) {
    __shared__ float red[4];
    const unsigned hs = hash_u(blockIdx.x * 32452843u + 31u); const int m = hs % MTOK, n = (hs >> 13) % DM;
    const bf16* hct = (const bf16*)(a.ws + WS_HACT) + (size_t)m * DFF; float a1 = 0.f;
    for (int k = threadIdx.x; k < DFF; k += 256) a1 += bf2f(hct[k]) * a.in[9][(size_t)k * DM + n];
    a1 = block_sum256(a1, red);
    if (threadIdx.x == 0) dbg_record(dbg, 18, a.out[(size_t)m * DM + n], ((const float*)(a.ws + WS_X1))[(size_t)m * DM + n] + a1, 0.05f);
}
__global__ void chk_w(Args a, float* dbg) {
    const unsigned hs = hash_u((blockIdx.x * 256 + threadIdx.x) * 2246822519u + 41u); const int k = hs % DM; const int sel = (hs >> 11) & 1;
    const int n = sel ? 6144 + ((hs >> 12) % 4096) : ((hs >> 12) % 3072);
    const float ref = a.in[2][(size_t)k * INC + (sel ? n + 8 : n)];
    dbg_record(dbg, sel ? 19 : 20, bf2f(((const bf16*)(a.ws + WS_WIN))[(size_t)n * DM + k]), ref, 0.002f);
}
__global__ void dbg_zero(float* dbg) { if (threadIdx.x < 64) dbg[threadIdx.x] = 0.f; }
__global__ void dbg_clear(float* out) { const size_t i = (size_t)blockIdx.x * blockDim.x + threadIdx.x; if (i < (size_t)MTOK * DM) out[i] = 0.f; }
__global__ void dbg_apply(const float* dbg, float* out, int only, float tol) {
    if (threadIdx.x != 0) return;
    if (only == 99 || only == 98 || only == 97 || only == 96) { float code = 0.f; const int k0 = only == 99 ? 21 : (only == 98 ? 26 : (only == 97 ? 32 : 40)); for (int k = k0; k < k0 + 6; ++k) if (dbg[k] < tol) code = code * 2.f + 1.f; else code = code * 2.f; out[0] += 1000.f * (code + 1.f); return; }
    if (only >= 100) { out[0] += 1e4f * dbg[only - 100]; return; }
    for (int k = 0; k < 21; ++k) if ((only < 0 || only == k) && dbg[k] > tol) { out[0] += 1000.f * (k + 1); return; }
}
#endif
extern "C" void kernel_launch(void* const* d_in, const int* in_sizes, int n_in, void* d_out, int out_size, void* d_ws, size_t ws_size, hipStream_t stream) {
    static int grid = 0;
    if (grid == 0) {
        if (n_in != 11 || out_size != MTOK * DM || ws_size < WS_END) { fprintf(stderr, "kernel_launch: unexpected shapes (n_in %d out %d ws %zu)\n", n_in, out_size, ws_size); grid = -1; return; }
        int dev = 0, cus = 0;
        if (hipGetDevice(&dev) != hipSuccess || hipDeviceGetAttribute(&cus, hipDeviceAttributeMultiprocessorCount, dev) != hipSuccess) { grid = -1; return; }
        if (hipFuncSetAttribute((const void*)mega, hipFuncAttributeMaxDynamicSharedMemorySize, LDS_BYTES) != hipSuccess) { fprintf(stderr, "kernel_launch: hipFuncSetAttribute failed\n"); grid = -1; return; }
        int per_cu = 0; (void)hipOccupancyMaxActiveBlocksPerMultiprocessor(&per_cu, (const void*)mega, NTHREADS, LDS_BYTES);
        if (per_cu < 1) { fprintf(stderr, "kernel_launch: occupancy query reports %d workgroups per CU\n", per_cu); grid = -1; return; }
        grid = cus;
        if (grid != 256) { fprintf(stderr, "kernel_launch: built for 256 CUs, got %d\n", grid); grid = -1; return; }
    }
    if (grid < 0) return;
    Args a{};
    for (int i = 0; i < 11; ++i) a.in[i] = (const float*)d_in[i];
    a.out = (float*)d_out; a.ws = (unsigned char*)d_ws;
    unsigned char* ws = (unsigned char*)d_ws;
    auto run = [&](int lo, int hi) { a.ph_lo = lo; a.ph_hi = hi; hipLaunchKernelGGL(mega, dim3(grid), dim3(NTHREADS), LDS_BYTES, stream, a); };
    const bf16* qkv = (const bf16*)(ws + WS_C);
    auto attn = [&]() {
        hipLaunchKernelGGL(scan_naive, dim3(1), dim3(32), 0, stream, (const float*)(ws + WS_LOGF), (float*)(ws + WS_CUM));
        hipLaunchKernelGGL(attn_naive<0>, dim3(BATCH * NH * SEQ / 4), dim3(256), 0, stream, qkv, qkv + QKV_ELEMS, qkv + 2 * QKV_ELEMS, (const float*)(ws + WS_CUM), (const float*)(ws + WS_KPART), (bf16*)(ws + WS_B));
        hipLaunchKernelGGL(attn_naive<1>, dim3(BATCH * NH * SEQ / 4), dim3(256), 0, stream, qkv + 3 * QKV_ELEMS, qkv + 4 * QKV_ELEMS, qkv + 5 * QKV_ELEMS, (const float*)(ws + WS_CUM), (const float*)(ws + WS_KPART), (bf16*)(ws + WS_B) + WID);
    };
#ifdef DEBUG_CHECKS
    float* dbg = (float*)(ws + WS_DBG); float* yref = dbg + 64; float* scr = (float*)(ws + WS_DBG + 65536);
    hipLaunchKernelGGL(dbg_zero, dim3(1), dim3(64), 0, stream, dbg);
    run(0, 1); hipLaunchKernelGGL(chk_p0, dim3(64), dim3(256), 0, stream, a, dbg); hipLaunchKernelGGL(chk_w, dim3(64), dim3(256), 0, stream, a, dbg);
    run(1, 2); hipLaunchKernelGGL(chk_in, dim3(8192), dim3(256), 0, stream, a, dbg); hipLaunchKernelGGL(chk_kpart, dim3(64), dim3(256), 0, stream, a, dbg);
    run(2, 3); hipLaunchKernelGGL(chk_attn, dim3(2), dim3(64), 0, stream, a, dbg, scr);
    hipLaunchKernelGGL(chk_y, dim3(256), dim3(256), 0, stream, a, dbg, yref, 0); run(3, 4); hipLaunchKernelGGL(chk_y, dim3(256), dim3(256), 0, stream, a, dbg, yref, 1);
    run(4, 5); hipLaunchKernelGGL(chk_x1, dim3(256), dim3(256), 0, stream, a, dbg);
    run(5, 6); hipLaunchKernelGGL(chk_hact, dim3(256), dim3(256), 0, stream, a, dbg);
    run(6, 7); hipLaunchKernelGGL(chk_x2, dim3(256), dim3(256), 0, stream, a, dbg);
    run(7, 8); if (DEBUG_ONLY >= 0) hipLaunchKernelGGL(dbg_clear, dim3(MTOK * DM / 256), dim3(256), 0, stream, (float*)d_out); hipLaunchKernelGGL(dbg_apply, dim3(1), dim3(64), 0, stream, (const float*)dbg, (float*)d_out, DEBUG_ONLY, DEBUG_TOL);
#else
    a.ph_lo = 0; a.ph_hi = 8;
    void* kargs[] = {&a};
    const hipError_t e = hipLaunchCooperativeKernel((const void*)mega, dim3(grid), dim3(NTHREADS), kargs, LDS_BYTES, stream);
    if (e != hipSuccess) fprintf(stderr, "kernel_launch: cooperative launch failed: %s (grid %d)\n", hipGetErrorString(e), grid);
#endif
}
```
